# Optimizing an MI355X kernel written in HIP

```python
import math
import jax, jax.numpy as jnp
from jax import lax
import numpy as np

D_MODEL = 1024
BATCH = 32
SEQ = 2048
DEPTH = 1

HEAD_DIM = 64
HEADS_PER_GROUP = 8
DILATED_GROUPS = ((128, 1), (512, 4), (2048, 16))
N_GROUPS = len(DILATED_GROUPS)
N_ATTN_HEADS = N_GROUPS * HEADS_PER_GROUP
ATTN_QKV = N_ATTN_HEADS * HEAD_DIM
ATTN_OUT = HEADS_PER_GROUP * HEAD_DIM
BLOCK = 128
NEG = -1e30
NUM_BUCKETS = 32
MAX_EXACT = NUM_BUCKETS // 2
MAX_DISTANCE = 2048
LRU_WIDTH = D_MODEL
LRU_BLOCKS = 16
LRU_BLOCK_W = LRU_WIDTH // LRU_BLOCKS
LRU_CONV = 4
C_RGLRU = 8.0
D_FF = 3 * D_MODEL
FFN_CONV = 3
IN_COLS = 3 * ATTN_QKV + 2 * LRU_WIDTH + 2 * D_MODEL
ALPHA = (2.0 * DEPTH) ** 0.25
BETA = (8.0 * DEPTH) ** -0.25
LN_EPS = 1e-5

kernel_name = "hybrid_dilated_attn_rglru_convffn_block"


def layer_norm(x, g, b):
    xf = x.astype(jnp.float32)
    mu = xf.mean(-1, keepdims=True)
    var = jnp.square(xf - mu).mean(-1, keepdims=True)
    return ((xf - mu) * lax.rsqrt(var + LN_EPS) * g + b).astype(x.dtype)


def causal_dwconv(x, w, b):
    K = w.shape[0]
    S = x.shape[1]
    xp = jnp.pad(x, ((0, 0), (K - 1, 0), (0, 0)))
    y = b
    for k in range(K):
        y = y + xp[:, k:k + S] * w[k]
    return y


def rel_bucket(dist):
    is_small = dist < MAX_EXACT
    nf = jnp.maximum(dist, 1).astype(jnp.float32)
    large = MAX_EXACT + (jnp.log(nf / MAX_EXACT) / math.log(MAX_DISTANCE / MAX_EXACT)
                         * (NUM_BUCKETS - MAX_EXACT)).astype(jnp.int32)
    large = jnp.minimum(large, NUM_BUCKETS - 1)
    return jnp.where(is_small, dist, large)


def dilated_window_attention(q, k, v, bias_table, window, dilation):
    B, S, H, Dh = q.shape
    span = dilation * BLOCK
    Sp = -(-S // span) * span
    L = Sp // dilation
    nblk = L // BLOCK

    def to_blocks(t):
        t = jnp.pad(t, ((0, 0), (0, Sp - S), (0, 0), (0, 0)))
        t = t.reshape(B, L, dilation, H, Dh).transpose(0, 2, 3, 1, 4)
        return t.reshape(B, dilation, H, nblk, BLOCK, Dh)

    def with_prev(t):
        prev = jnp.pad(t, ((0, 0), (0, 0), (0, 0), (1, 0), (0, 0), (0, 0)))[:, :, :, :-1]
        return jnp.concatenate([prev, t], axis=4)

    qb = to_blocks(q * (HEAD_DIM ** -0.5))
    kk = with_prev(to_blocks(k))
    vv = with_prev(to_blocks(v))
    logits = jnp.einsum('brhnqc,brhnkc->brhnqk', qb, kk).astype(jnp.float32)

    qi = jnp.arange(BLOCK)[:, None]
    kj = jnp.arange(2 * BLOCK)[None, :]
    dist = qi + BLOCK - kj
    in_band = (dist >= 0) & (dist <= window // dilation)
    bucket = rel_bucket(jnp.maximum(dist, 0) * dilation)
    bias = bias_table[bucket].astype(jnp.float32).transpose(2, 0, 1)
    blk = jnp.arange(nblk)[:, None, None]
    mask = in_band[None] & ((blk > 0) | (kj >= BLOCK)[None])

    logits = jnp.where(mask, logits + bias[:, None], NEG)
    m = logits.max(-1, keepdims=True)
    p = jnp.exp(logits - m)
    s = p.sum(-1, keepdims=True)
    o = jnp.einsum('brhnqk,brhnkc->brhnqc', p, vv.astype(jnp.float32)) / s
    lse = (m + jnp.log(s))[..., 0]
    o = o.reshape(B, dilation, H, L, Dh).transpose(0, 3, 1, 2, 4).reshape(B, Sp, H, Dh)[:, :S]
    lse = lse.reshape(B, dilation, H, L).transpose(0, 3, 1, 2).reshape(B, Sp, H)[:, :S]
    return o, lse


def rg_lru(xr, wa, ba, wx, bx, lam):
    B, S, W = xr.shape
    xf = xr.astype(jnp.float32)
    xb = xf.reshape(B, S, LRU_BLOCKS, LRU_BLOCK_W)
    ba_b = ba.astype(jnp.float32).reshape(LRU_BLOCKS, LRU_BLOCK_W)
    bx_b = bx.astype(jnp.float32).reshape(LRU_BLOCKS, LRU_BLOCK_W)
    r = jax.nn.sigmoid(jnp.einsum('bsnc,ncd->bsnd', xb, wa.astype(jnp.float32)) + ba_b).reshape(B, S, W)
    i = jax.nn.sigmoid(jnp.einsum('bsnc,ncd->bsnd', xb, wx.astype(jnp.float32)) + bx_b).reshape(B, S, W)
    log_a = -C_RGLRU * r * jax.nn.softplus(-lam.astype(jnp.float32))
    a = jnp.exp(log_a)
    b = jnp.sqrt(-jnp.expm1(2.0 * log_a)) * (i * xf)

    def combine(left, right):
        a1, b1 = left
        a2, b2 = right
        return a1 * a2, a2 * b1 + b2

    _, h = lax.associative_scan(combine, (a, b), axis=1)
    return h.astype(xr.dtype)


def setup_inputs(seed: int = 0) -> dict:
    key = jax.random.key(seed)
    ks = jax.random.split(key, 24)
    f32 = jnp.float32
    nrm = lambda k, shape, scale: jax.random.normal(k, shape, f32) * scale
    D = D_MODEL
    w_in = nrm(ks[2], (DEPTH, D, IN_COLS), D ** -0.5)
    w_in = w_in.at[:, :, 2 * ATTN_QKV:3 * ATTN_QKV].multiply(BETA)
    a_c = jax.random.uniform(ks[10], (DEPTH, LRU_WIDTH), f32, 0.9, 0.999)
    a0 = a_c ** (1.0 / C_RGLRU)
    lam = jnp.log(a0) - jnp.log1p(-a0)
    return {
        "x": nrm(ks[0], (BATCH, SEQ, D), 1.0),
        "c": nrm(ks[1], (BATCH, D), 1.0),
        "w_ada": nrm(ks[3], (DEPTH, D, 6 * D), D ** -0.5),
        "b_ada": nrm(ks[4], (DEPTH, 6 * D), 0.01),
        "w_in": w_in,
        "rel_bias": nrm(ks[5], (NUM_BUCKETS, N_ATTN_HEADS), 0.5),
        "lru_conv_w": nrm(ks[6], (DEPTH, LRU_CONV, LRU_WIDTH), LRU_CONV ** -0.5),
        "lru_conv_b": nrm(ks[7], (DEPTH, LRU_WIDTH), 0.01),
        "lru_wa": nrm(ks[8], (DEPTH, LRU_BLOCKS, LRU_BLOCK_W, LRU_BLOCK_W), LRU_BLOCK_W ** -0.5),
        "lru_ba": nrm(ks[9], (DEPTH, LRU_WIDTH), 0.01),
        "lru_wx": nrm(ks[11], (DEPTH, LRU_BLOCKS, LRU_BLOCK_W, LRU_BLOCK_W), LRU_BLOCK_W ** -0.5),
        "lru_bx": nrm(ks[12], (DEPTH, LRU_WIDTH), 0.01),
        "lru_lambda": lam,
        "w_proj_attn": nrm(ks[13], (DEPTH, ATTN_OUT, D), BETA * ATTN_OUT ** -0.5),
        "w_proj_lru": nrm(ks[14], (DEPTH, LRU_WIDTH, D), BETA * LRU_WIDTH ** -0.5),
        "w_out": nrm(ks[15], (DEPTH, D, D), BETA * D ** -0.5),
        "ln1_g": 1.0 + nrm(ks[16], (DEPTH, D), 0.02),
        "ln1_b": nrm(ks[17], (DEPTH, D), 0.02),
        "ffn_w_up": nrm(ks[18], (DEPTH, D, 2 * D_FF), D ** -0.5),
        "ffn_conv_w": nrm(ks[19], (DEPTH, FFN_CONV, 2 * D_FF), FFN_CONV ** -0.5),
        "ffn_conv_b": nrm(ks[20], (DEPTH, 2 * D_FF), 0.01),
        "ffn_w_down": nrm(ks[21], (DEPTH, D_FF, D), BETA * D_FF ** -0.5),
        "ln2_g": 1.0 + nrm(ks[22], (DEPTH, D), 0.02),
        "ln2_b": nrm(ks[23], (DEPTH, D), 0.02),
    }


def reference(x, c, w_ada, b_ada, w_in, rel_bias, lru_conv_w, lru_conv_b, lru_wa, lru_ba,
              lru_wx, lru_bx, lru_lambda, w_proj_attn, w_proj_lru, w_out, ln1_g, ln1_b,
              ffn_w_up, ffn_conv_w, ffn_conv_b, ffn_w_down, ln2_g, ln2_b):
    B, S, D = x.shape
    c_act = jax.nn.silu(c)
    split_idx = [ATTN_QKV, 2 * ATTN_QKV, 3 * ATTN_QKV, 3 * ATTN_QKV + LRU_WIDTH,
                 3 * ATTN_QKV + 2 * LRU_WIDTH, 3 * ATTN_QKV + 2 * LRU_WIDTH + D_MODEL]
    for l in range(DEPTH):
        mod = c_act @ w_ada[l] + b_ada[l]
        sh1, sc1, g1, sh2, sc2, g2 = [t[:, None, :] for t in jnp.split(mod, 6, axis=-1)]

        u = x * (1.0 + sc1) + sh1
        proj = u @ w_in[l]
        q, k, v, x_lru, lru_gate, gate_a, gate_r = jnp.split(proj, split_idx, axis=-1)
        q = q.reshape(B, S, N_GROUPS, HEADS_PER_GROUP, HEAD_DIM)
        k = k.reshape(B, S, N_GROUPS, HEADS_PER_GROUP, HEAD_DIM)
        v = v.reshape(B, S, N_GROUPS, HEADS_PER_GROUP, HEAD_DIM)
        outs, lses = [], []
        for g, (window, dilation) in enumerate(DILATED_GROUPS):
            o_g, lse_g = dilated_window_attention(
                q[:, :, g], k[:, :, g], v[:, :, g],
                rel_bias[:, g * HEADS_PER_GROUP:(g + 1) * HEADS_PER_GROUP], window, dilation)
            outs.append(o_g)
            lses.append(lse_g)
        wts = jax.nn.softmax(jnp.stack(lses, 0), axis=0)
        o_attn = jnp.sum(wts[..., None] * jnp.stack(outs, 0), axis=0)
        y_attn = o_attn.reshape(B, S, ATTN_OUT).astype(x.dtype) @ w_proj_attn[l]

        xr = causal_dwconv(x_lru, lru_conv_w[l], lru_conv_b[l])
        h = rg_lru(xr, lru_wa[l], lru_ba[l], lru_wx[l], lru_bx[l], lru_lambda[l])
        y_lru = (h * jax.nn.gelu(lru_gate)) @ w_proj_lru[l]

        merged = jax.nn.sigmoid(gate_a) * y_attn + jax.nn.sigmoid(gate_r) * y_lru
        mix_out = merged @ w_out[l]
        x = layer_norm(ALPHA * x + g1 * mix_out, ln1_g[l], ln1_b[l])

        u2 = x * (1.0 + sc2) + sh2
        hff = causal_dwconv(u2 @ ffn_w_up[l], ffn_conv_w[l], ffn_conv_b[l])
        val, gt = jnp.split(hff, 2, axis=-1)
        ffn_out = (jax.nn.gelu(gt) * val) @ ffn_w_down[l]
        x = layer_norm(ALPHA * x + g2 * ffn_out, ln2_g[l], ln2_b[l])
    return x
```

```cpp
#include <hip/hip_runtime.h>
#include <hip/hip_cooperative_groups.h>
#include <cstdio>
#include <cstdint>
namespace cg = cooperative_groups;

#define LAS __attribute__((address_space(3)))
typedef unsigned short bf16_t;
typedef short bf16x8 __attribute__((ext_vector_type(8)));
typedef short s16x4 __attribute__((ext_vector_type(4)));
typedef float f32x4 __attribute__((ext_vector_type(4)));
typedef unsigned u32x4 __attribute__((ext_vector_type(4)));
typedef unsigned u32x2 __attribute__((ext_vector_type(2)));

constexpr int D = 1024, NB = 32, SEQ = 2048, MTOT = NB * SEQ;
constexpr int QKV = 1536, INC = 8704, FF = 3072, FF2 = 6144, AOUT = 512;
constexpr int OFF_Q = 0, OFF_K = 1536, OFF_V = 3072, OFF_XL = 4608, OFF_LG = 5632, OFF_GA = 6656, OFF_GR = 7680;
constexpr int CB = 8;
constexpr int MC = CB * SEQ;
constexpr int NCH = NB / CB;
constexpr float ALPHA = 1.189207115002721f;
constexpr float LN_EPS = 1e-5f;
constexpr int MOD6 = 6 * D;

constexpr size_t MiB = 1u << 20;
constexpr size_t WS_CTL = 0, CTL_BYTES = 64 * 1024;
constexpr size_t WS_MOD = 1 * MiB;
constexpr size_t WS_WIN = 2 * MiB;
constexpr size_t WS_WPA = WS_WIN + (size_t)INC * D * 2;
constexpr size_t WS_WPL = WS_WPA + (size_t)D * AOUT * 2;
constexpr size_t WS_WOUT = WS_WPL + (size_t)D * D * 2;
constexpr size_t WS_WUP = WS_WOUT + (size_t)D * D * 2;
constexpr size_t WS_WDN = WS_WUP + (size_t)FF2 * D * 2;
constexpr size_t WS_WLRU = WS_WDN + (size_t)D * FF * 2;
constexpr size_t WS_WEND = WS_WLRU + 2 * 16 * 64 * 64 * 2;
static_assert(WS_WEND <= 50 * MiB, "weights region");
constexpr size_t WS_U = 50 * MiB;
constexpr size_t WS_PROJ = WS_U + (size_t)MC * D * 2;
constexpr size_t WS_OG = WS_PROJ + (size_t)MC * INC * 2;
constexpr size_t WS_LSE = WS_OG + (size_t)3 * MC * AOUT * 2;
constexpr size_t WS_OATT = WS_LSE + (size_t)3 * MC * 8 * 4;
constexpr size_t WS_HG = WS_OATT + (size_t)MC * AOUT * 2;
constexpr size_t WS_YAG = WS_HG + (size_t)MC * D * 2;
constexpr size_t WS_MRG = WS_YAG + (size_t)MC * D * 2;
constexpr size_t WS_X1 = WS_MRG + (size_t)MC * D * 2;
constexpr size_t WS_UP = WS_X1 + (size_t)MC * D * 4;
constexpr size_t WS_ACT = WS_UP + (size_t)MC * FF2 * 2;
constexpr size_t WS_END = WS_ACT + (size_t)MC * FF * 2;
static_assert(WS_END <= 1024 * MiB, "workspace");

constexpr int LDS_BYTES = 147456;
#ifndef PROBE
#define PROBE 0
#endif

__device__ __forceinline__ unsigned f2bf(float f) { unsigned u = __builtin_bit_cast(unsigned, f); return (u + 0x7fffu + ((u >> 16) & 1u)) >> 16; }
__device__ __forceinline__ unsigned pk2(float lo, float hi) { unsigned r; asm("v_cvt_pk_bf16_f32 %0, %1, %2" : "=v"(r) : "v"(lo), "v"(hi)); return r; }
__device__ __forceinline__ int opaque_tid() { int t = threadIdx.x; asm volatile("" : "+v"(t)); return t; }
__device__ __forceinline__ float bflo(unsigned u) { return __builtin_bit_cast(float, u << 16); }
__device__ __forceinline__ float bfhi(unsigned u) { return __builtin_bit_cast(float, u & 0xffff0000u); }
__device__ __forceinline__ float sigmoidf_(float x) { return 1.0f / (1.0f + __expf(-x)); }
__device__ __forceinline__ float gelu_tanh(float x) { const float u = 1.5957691216057308f * (x + 0.044715f * x * x * x); return x * sigmoidf_(u); }
__device__ __forceinline__ float wave_sum(float v) {
#pragma unroll
    for (int o = 1; o < 64; o <<= 1) v += __shfl_xor(v, o);
    return v;
}

namespace pg8 {
constexpr int BM = 256, BK = 64, HALF = 128, HTB = HALF * BK * 2, STAGE_BYTES = 8 * HTB, NXCD = 8, WGM = 8;
__host__ __device__ __forceinline__ int lds_byte(int r, int c) { const int st = (r >> 4) * 2 + (c >> 5), rr = r & 15, cc = c & 31, ob = rr * 64 + cc * 2; return st * 1024 + (ob ^ (((ob >> 9) & 1) << 5)); }
__host__ __device__ __forceinline__ void stage_rc(int b, int& R, int& C) { const int st = b / 1024, sb = b % 1024, swz = sb ^ (((sb >> 9) & 1) << 5); R = (st >> 1) * 16 + swz / 64; C = (st & 1) * 32 + (swz % 64) / 2; }
__host__ __device__ __forceinline__ int perm32(int rho) { const int n = rho >> 4, i = rho & 15; return 8 * (i >> 2) + 4 * n + (i & 3); }

struct Unit { int pm, pn; };
struct Gemm { const bf16_t* A; const bf16_t* Bt; int M, N, K, lda; };

struct StaticOrder {
    int nM, nN, nwg, G, c;
    __device__ void init(int M, int N, int G_, int c_) { nM = M / BM; nN = N / BM; nwg = nM * nN; G = G_; c = c_; }
    __device__ bool next(int i, Unit& u) const {
        const long L = (long)i * G + c; if (L >= nwg) return false;
        int wgid = (int)L; { const int q = nwg / NXCD, r = nwg % NXCD, xcd = wgid % NXCD, off = wgid / NXCD; wgid = (xcd < r ? xcd * (q + 1) : r * (q + 1) + (xcd - r) * q) + off; }
        const int nig = WGM * nN, gid = wgid / nig, fm = gid * WGM, gsz = (nM - fm) < WGM ? (nM - fm) : WGM;
        u.pm = fm + ((wgid % nig) % gsz); u.pn = (wgid % nig) / gsz; return true;
    }
};

template <class Epi, class Sched, bool ALIGN_EPI, bool SP2>
__device__ __forceinline__ void gemm_phase(LAS unsigned char* lds, const Gemm g, const Sched& S, const Epi& E) {
    const int tid = opaque_tid(), wid = __builtin_amdgcn_readfirstlane(tid >> 6), lane = tid & 63, wr = wid >> 2, wc = wid & 3, fr = lane & 15, fq = lane >> 4;
    const int K = g.K, nt = K / BK, lda = g.lda;
    unsigned voffA[2], voffB[2];
#pragma unroll
    for (int i = 0; i < 2; ++i) { int R, C; stage_rc(tid * 16 + i * 8192, R, C); const int Rb = Epi::PERM ? ((R & ~31) + perm32(R & 31)) : R;
        voffA[i] = (unsigned)(R * lda + C) * 2u; voffB[i] = (unsigned)(Rb * K + C) * 2u; }
    const size_t kstep = (size_t)(BK * 2);
    const size_t hstepA = (size_t)HALF * lda * 2, hstepB = (size_t)HALF * K * 2;
    const size_t tstepA = 2 * hstepA, tstepB = 2 * hstepB;
    const unsigned ldsw = (unsigned)wid * 1024u;
    const int aoff = lds_byte(wr * 64 + fr, fq * 8), boff = lds_byte(wc * 32 + fr, fq * 8);
#define PG8_SA(b, h) (((b) * 2 + (h)) * HTB)
#define PG8_SB(b, h) ((4 + (b) * 2 + (h)) * HTB)
#define PG8_STAGE(bufoff, gbase, voff) do { _Pragma("unroll") for (int _i = 0; _i < 2; ++_i) \
        __builtin_amdgcn_global_load_lds((const unsigned*)((const char*)(gbase) + (voff)[_i]), (LAS unsigned*)(lds + (bufoff) + ldsw + _i * 8192), 16, 0, 0); } while (0)
#define PG8_LDA(dst, b, h) do { _Pragma("unroll") for (int m = 0; m < 4; ++m) _Pragma("unroll") for (int k = 0; k < 2; ++k) dst[m][k] = *(const LAS bf16x8*)(lds + PG8_SA(b, h) + aoff + m * 2048 + k * 1024); } while (0)
#define PG8_LDB(dst, b, h) do { _Pragma("unroll") for (int n = 0; n < 2; ++n) _Pragma("unroll") for (int k = 0; k < 2; ++k) dst[n][k] = *(const LAS bf16x8*)(lds + PG8_SB(b, h) + boff + n * 2048 + k * 1024); } while (0)
#define PG8_MMA(ai, bj, At, Bt) do { __builtin_amdgcn_s_setprio(1); _Pragma("unroll") for (int m = 0; m < 4; ++m) _Pragma("unroll") for (int n = 0; n < 2; ++n) _Pragma("unroll") for (int k = 0; k < 2; ++k) \
        acc[ai][bj][m][n] = __builtin_amdgcn_mfma_f32_16x16x32_bf16(Bt[n][k], At[m][k], acc[ai][bj][m][n], 0, 0, 0); __builtin_amdgcn_s_setprio(0); } while (0)
#define PG8_WAIT_V(n) asm volatile("s_waitcnt vmcnt(" #n ")" ::: "memory")
#define PG8_WAIT_L(n) asm volatile("s_waitcnt lgkmcnt(" #n ")" ::: "memory")
#define PG8_BAR __builtin_amdgcn_s_barrier()
#define PG8_SCHED __builtin_amdgcn_sched_barrier(0)
    Unit cur, nxt; int ui = 0;
    if (!S.next(0, cur)) return;
    f32x4 acc[2][2][4][2];
#pragma unroll
    for (int a = 0; a < 2; ++a)
#pragma unroll
        for (int b = 0; b < 2; ++b)
#pragma unroll
            for (int m = 0; m < 4; ++m)
#pragma unroll
                for (int n = 0; n < 2; ++n) acc[a][b][m][n] = (f32x4){0.f, 0.f, 0.f, 0.f};
    bf16x8 At[4][2], B0[2][2], B1[2][2];
    const char* cA = (const char*)g.A + (size_t)cur.pm * tstepA; const char* cB = (const char*)g.Bt + (size_t)cur.pn * tstepB;
    if constexpr (SP2) {
        PG8_STAGE(PG8_SB(0, 0), cB, voffB); PG8_STAGE(PG8_SB(0, 1), cB + hstepB, voffB); PG8_STAGE(PG8_SA(0, 0), cA, voffA); PG8_STAGE(PG8_SA(0, 1), cA + hstepA, voffA);
        if (wr == 1) PG8_BAR;
        PG8_WAIT_V(2); PG8_BAR;
        PG8_STAGE(PG8_SB(1, 0), cB + kstep, voffB); PG8_STAGE(PG8_SA(1, 0), cA + kstep, voffA); PG8_STAGE(PG8_SB(1, 1), cB + hstepB + kstep, voffB);
        PG8_WAIT_V(6); PG8_BAR;
    } else {
        PG8_STAGE(PG8_SB(0, 0), cB, voffB); PG8_STAGE(PG8_SA(0, 0), cA, voffA); PG8_STAGE(PG8_SB(0, 1), cB + hstepB, voffB); PG8_STAGE(PG8_SA(0, 1), cA + hstepA, voffA);
        if (wr == 1) PG8_BAR;
        PG8_WAIT_V(4); PG8_BAR;
        PG8_STAGE(PG8_SB(1, 0), cB + kstep, voffB); PG8_STAGE(PG8_SA(1, 0), cA + kstep, voffA); PG8_STAGE(PG8_SB(1, 1), cB + hstepB + kstep, voffB);
        PG8_WAIT_V(6); PG8_BAR;
    }
    for (;;) {
        const bool has_next = S.next(ui + 1, nxt);
        const char* nA = has_next ? (const char*)g.A + (size_t)nxt.pm * tstepA : cA; const char* nB = has_next ? (const char*)g.Bt + (size_t)nxt.pn * tstepB : cB;
        for (int t = 0; t < nt; t += 2) {
            const bool last = (t == nt - 2);
            const char* a1 = cA + (size_t)(t + 1) * kstep;
            const char* a2 = last ? nA : cA + (size_t)(t + 2) * kstep; const char* b2 = last ? nB : cB + (size_t)(t + 2) * kstep;
            const char* a3 = a2 + kstep; const char* b3 = b2 + kstep;
            if constexpr (SP2) {
            PG8_LDB(B0, 0, 0); PG8_LDB(B1, 0, 1); PG8_SCHED; PG8_LDA(At, 0, 0); PG8_STAGE(PG8_SA(1, 1), a1 + hstepA, voffA);
            PG8_WAIT_V(8); PG8_WAIT_L(0); PG8_BAR; PG8_MMA(0, 0, At, B0); PG8_MMA(0, 1, At, B1); PG8_BAR; PG8_SCHED;
            PG8_LDA(At, 0, 1); PG8_STAGE(PG8_SB(0, 0), b2, voffB); PG8_STAGE(PG8_SB(0, 1), b2 + hstepB, voffB); PG8_STAGE(PG8_SA(0, 0), a2, voffA);
            PG8_WAIT_V(8); PG8_WAIT_L(0); PG8_BAR; PG8_MMA(1, 0, At, B0); PG8_MMA(1, 1, At, B1); PG8_BAR; PG8_SCHED;
            PG8_LDB(B0, 1, 0); PG8_LDB(B1, 1, 1); PG8_SCHED; PG8_LDA(At, 1, 0); PG8_STAGE(PG8_SA(0, 1), a2 + hstepA, voffA);
            PG8_WAIT_V(8); PG8_WAIT_L(0); PG8_BAR; PG8_MMA(0, 0, At, B0); PG8_MMA(0, 1, At, B1); PG8_BAR; PG8_SCHED;
            PG8_LDA(At, 1, 1); PG8_STAGE(PG8_SB(1, 0), b3, voffB); PG8_STAGE(PG8_SB(1, 1), b3 + hstepB, voffB); PG8_STAGE(PG8_SA(1, 0), a3, voffA);
            PG8_WAIT_V(8); PG8_WAIT_L(0); PG8_BAR; PG8_MMA(1, 0, At, B0); PG8_MMA(1, 1, At, B1); PG8_BAR; PG8_SCHED;
            } else {
            PG8_LDB(B0, 0, 0); PG8_SCHED; PG8_LDA(At, 0, 0); PG8_STAGE(PG8_SA(1, 1), a1 + hstepA, voffA);
            PG8_WAIT_L(8); PG8_BAR; PG8_WAIT_L(0); PG8_MMA(0, 0, At, B0); PG8_BAR; PG8_SCHED;
            PG8_LDB(B1, 0, 1); PG8_STAGE(PG8_SB(0, 0), b2, voffB);
            PG8_BAR; PG8_WAIT_L(0); PG8_MMA(0, 1, At, B1); PG8_BAR;
            PG8_LDA(At, 0, 1); PG8_STAGE(PG8_SA(0, 0), a2, voffA);
            PG8_BAR; PG8_WAIT_L(0); PG8_MMA(1, 0, At, B0); PG8_BAR; PG8_SCHED;
            PG8_STAGE(PG8_SB(0, 1), b2 + hstepB, voffB);
            PG8_WAIT_V(6); PG8_BAR; PG8_MMA(1, 1, At, B1); PG8_BAR;
            PG8_LDB(B0, 1, 0); PG8_SCHED; PG8_LDA(At, 1, 0); PG8_STAGE(PG8_SA(0, 1), a2 + hstepA, voffA);
            PG8_WAIT_L(8); PG8_BAR; PG8_WAIT_L(0); PG8_MMA(0, 0, At, B0); PG8_BAR; PG8_SCHED;
            PG8_LDB(B1, 1, 1); PG8_STAGE(PG8_SB(1, 0), b3, voffB);
            PG8_BAR; PG8_WAIT_L(0); PG8_MMA(0, 1, At, B1); PG8_BAR;
            PG8_LDA(At, 1, 1); PG8_STAGE(PG8_SA(1, 0), a3, voffA);
            PG8_BAR; PG8_WAIT_L(0); PG8_MMA(1, 0, At, B0); PG8_BAR; PG8_SCHED;
            PG8_STAGE(PG8_SB(1, 1), b3 + hstepB, voffB);
            PG8_WAIT_V(6); PG8_BAR; PG8_MMA(1, 1, At, B1); PG8_BAR;
            }
        }
        if constexpr (ALIGN_EPI) { if (wr == 0) PG8_BAR; }
        E(acc, cur, wr, wc, fr, fq);
        if (!has_next) break;
#pragma unroll
        for (int a = 0; a < 2; ++a)
#pragma unroll
            for (int b = 0; b < 2; ++b)
#pragma unroll
                for (int m = 0; m < 4; ++m)
#pragma unroll
                    for (int n = 0; n < 2; ++n) acc[a][b][m][n] = (f32x4){0.f, 0.f, 0.f, 0.f};
        cur = nxt; cA = nA; cB = nB; ++ui;
        if constexpr (ALIGN_EPI) { if (wr == 1) PG8_BAR; }
    }
    PG8_WAIT_V(0);
    if constexpr (!ALIGN_EPI) { if (wr == 0) PG8_BAR; }
    PG8_BAR;
#undef PG8_SA
#undef PG8_SB
#undef PG8_STAGE
#undef PG8_LDA
#undef PG8_LDB
#undef PG8_MMA
#undef PG8_WAIT_V
#undef PG8_WAIT_L
#undef PG8_BAR
#undef PG8_SCHED
}

template <int MODE> struct EpiBf {
    static constexpr bool PERM = true;
    bf16_t* O; int ldc; const bf16_t* gate; int ldg; const bf16_t* addend;
    __device__ __forceinline__ void operator()(const f32x4 (&acc)[2][2][4][2], const Unit& u, int wr, int wc, int fr, int fq) const {
        const int row0 = u.pm * BM + wr * 64 + fr, col0 = u.pn * BM + wc * 32 + 8 * fq;
#pragma unroll
        for (int ai = 0; ai < 2; ++ai)
#pragma unroll
            for (int m = 0; m < 4; ++m) { const size_t row = (size_t)(row0 + ai * HALF + m * 16);
#pragma unroll
                for (int bj = 0; bj < 2; ++bj) { f32x4 v0 = acc[ai][bj][m][0], v1 = acc[ai][bj][m][1]; const int col = col0 + bj * HALF;
                    if (MODE >= 1) { const u32x4 gv = *(const u32x4*)(gate + row * ldg + col);
                        v0[0] *= sigmoidf_(bflo(gv.x)); v0[1] *= sigmoidf_(bfhi(gv.x)); v0[2] *= sigmoidf_(bflo(gv.y)); v0[3] *= sigmoidf_(bfhi(gv.y));
                        v1[0] *= sigmoidf_(bflo(gv.z)); v1[1] *= sigmoidf_(bfhi(gv.z)); v1[2] *= sigmoidf_(bflo(gv.w)); v1[3] *= sigmoidf_(bfhi(gv.w)); }
                    if (MODE == 2) { const u32x4 av = *(const u32x4*)(addend + row * ldc + col);
                        v0[0] += bflo(av.x); v0[1] += bfhi(av.x); v0[2] += bflo(av.y); v0[3] += bfhi(av.y);
                        v1[0] += bflo(av.z); v1[1] += bfhi(av.z); v1[2] += bflo(av.w); v1[3] += bfhi(av.w); }
                    u32x4 w; w.x = pk2(v0[0], v0[1]); w.y = pk2(v0[2], v0[3]); w.z = pk2(v1[0], v1[1]); w.w = pk2(v1[2], v1[3]);
                    *(u32x4*)(O + row * ldc + col) = w; } }
    }
};
struct EpiResid {
    static constexpr bool PERM = false;
    float* out; const float* base; const float* gvec;
    __device__ __forceinline__ void operator()(const f32x4 (&acc)[2][2][4][2], const Unit& u, int wr, int wc, int fr, int fq) const {
        const int row0 = u.pm * BM + wr * 64 + fr, col0 = u.pn * BM + wc * 32 + 4 * fq;
        const float* gv = gvec + (size_t)(row0 >> 11) * MOD6 + col0;
        f32x4 g4[2][2];
#pragma unroll
        for (int bj = 0; bj < 2; ++bj)
#pragma unroll
            for (int n = 0; n < 2; ++n) g4[bj][n] = *(const f32x4*)(gv + bj * HALF + n * 16);
#pragma unroll
        for (int ai = 0; ai < 2; ++ai)
#pragma unroll
            for (int m = 0; m < 4; ++m) { const size_t off = (size_t)(row0 + ai * HALF + m * 16) * D + col0;
#pragma unroll
                for (int bj = 0; bj < 2; ++bj)
#pragma unroll
                    for (int n = 0; n < 2; ++n) { const f32x4 bs = *(const f32x4*)(base + off + bj * HALF + n * 16);
                        *(f32x4*)(out + off + bj * HALF + n * 16) = bs * ALPHA + g4[bj][n] * acc[ai][bj][m][n]; } }
    }
};
}

struct Params { const float* in[24]; float* out; unsigned char* ws; };
enum { I_X = 0, I_C, I_WADA, I_BADA, I_WIN, I_RELB, I_LCW, I_LCB, I_LWA, I_LBA, I_LWX, I_LBX, I_LLAM, I_WPA, I_WPL, I_WOUT, I_LN1G, I_LN1B, I_WUP, I_FCW, I_FCB, I_WDN, I_LN2G, I_LN2B };

__device__ __forceinline__ void p0_transpose_item(const float* W, int K, int N, bf16_t* WT, float* scr, int item, int lane) {
    const int nblk = N / 32, kb = item / nblk, nb = item % nblk, k0 = 64 * kb, n0 = 32 * nb;
#pragma unroll 8
    for (int i = 0; i < 32; ++i) { const int kk = 2 * i + (lane >> 5); scr[kk * 33 + (lane & 31)] = W[(size_t)(k0 + kk) * N + n0 + (lane & 31)]; }
    asm volatile("s_waitcnt lgkmcnt(0)" ::: "memory");
    const int c = lane & 7;
#pragma unroll
    for (int j = 0; j < 4; ++j) { const int n = (lane >> 3) + 8 * j; const float* s = scr + (8 * c) * 33 + n;
        u32x4 o; o.x = pk2(s[0 * 33], s[1 * 33]); o.y = pk2(s[2 * 33], s[3 * 33]); o.z = pk2(s[4 * 33], s[5 * 33]); o.w = pk2(s[6 * 33], s[7 * 33]);
        *(u32x4*)(WT + (size_t)(n0 + n) * K + k0 + 8 * c) = o; }
    asm volatile("s_waitcnt lgkmcnt(0)" ::: "memory");
}

__device__ __forceinline__ void phase0(const Params& p, unsigned char* smem, int bid, int G) {
    const int tid = opaque_tid(), lane = tid & 63, wave = tid >> 6;
    unsigned char* ws = p.ws;
    for (int j = bid; j < 96; j += G) {
        float* sc = (float*)smem;
        for (int i = tid; i < NB * D; i += 512) { const int b = i & 31, k = i >> 5; const float v = p.in[I_C][b * D + k]; sc[k * 32 + b] = v / (1.0f + __expf(-v)); }
        __syncthreads();
        const int col = 64 * j + lane, b0 = 4 * wave;
        const float* wp = p.in[I_WADA] + col;
        f32x4 acc = (f32x4){0.f, 0.f, 0.f, 0.f};
#pragma unroll 16
        for (int k = 0; k < D; ++k) { const float wv = wp[(size_t)k * MOD6]; const f32x4 s = *(const f32x4*)(sc + k * 32 + b0); acc += s * wv; }
        const float bb = p.in[I_BADA][col];
        float* mod = (float*)(ws + WS_MOD);
#pragma unroll
        for (int i = 0; i < 4; ++i) mod[(size_t)(b0 + i) * MOD6 + col] = acc[i] + bb;
        __syncthreads();
    }
    float* scr = (float*)(smem + wave * 16384);
    const int gw = bid * 8 + wave, NGW = G * 8;
    constexpr int I_1 = (D / 64) * (INC / 32), I_2 = (AOUT / 64) * (D / 32), I_3 = (D / 64) * (D / 32), I_4 = I_3, I_5 = (D / 64) * (FF2 / 32), I_6 = (FF / 64) * (D / 32), I_7 = 16 * 2;
    constexpr int NIT = I_1 + I_2 + I_3 + I_4 + I_5 + I_6 + 2 * I_7;
    for (int it = gw; it < NIT; it += NGW) {
        int r = it;
        if (r < I_1) { p0_transpose_item(p.in[I_WIN], D, INC, (bf16_t*)(ws + WS_WIN), scr, r, lane); continue; } r -= I_1;
        if (r < I_2) { p0_transpose_item(p.in[I_WPA], AOUT, D, (bf16_t*)(ws + WS_WPA), scr, r, lane); continue; } r -= I_2;
        if (r < I_3) { p0_transpose_item(p.in[I_WPL], D, D, (bf16_t*)(ws + WS_WPL), scr, r, lane); continue; } r -= I_3;
        if (r < I_4) { p0_transpose_item(p.in[I_WOUT], D, D, (bf16_t*)(ws + WS_WOUT), scr, r, lane); continue; } r -= I_4;
        if (r < I_5) { p0_transpose_item(p.in[I_WUP], D, FF2, (bf16_t*)(ws + WS_WUP), scr, r, lane); continue; } r -= I_5;
        if (r < I_6) { p0_transpose_item(p.in[I_WDN], FF, D, (bf16_t*)(ws + WS_WDN), scr, r, lane); continue; } r -= I_6;
        if (r < I_7) { const int blk = r >> 1; p0_transpose_item(p.in[I_LWA] + blk * 4096, 64, 64, (bf16_t*)(ws + WS_WLRU) + blk * 4096, scr, r & 1, lane); continue; } r -= I_7;
        { const int blk = r >> 1; p0_transpose_item(p.in[I_LWX] + blk * 4096, 64, 64, (bf16_t*)(ws + WS_WLRU) + 65536 + blk * 4096, scr, r & 1, lane); }
    }
}

__device__ __forceinline__ void phase_modx(const Params& p, int chunk, int bid, int G) {
    const float* x = p.in[I_X] + (size_t)chunk * MC * D;
    const float* mod = (const float*)(p.ws + WS_MOD) + (size_t)chunk * CB * MOD6;
    bf16_t* U = (bf16_t*)(p.ws + WS_U);
    const int nthr = G * 512;
    for (int i = bid * 512 + opaque_tid(); i < MC * D / 8; i += nthr) {
        const int row = i >> 7, c8 = (i & 127) * 8, b = row >> 11;
        const float* mp = mod + (size_t)b * MOD6 + c8;
        const f32x4 x0 = *(const f32x4*)(x + (size_t)row * D + c8), x1 = *(const f32x4*)(x + (size_t)row * D + c8 + 4);
        const f32x4 sh0 = *(const f32x4*)(mp), sh1 = *(const f32x4*)(mp + 4), sc0 = *(const f32x4*)(mp + D), sc1 = *(const f32x4*)(mp + D + 4);
        const f32x4 u0 = x0 * (sc0 + 1.0f) + sh0, u1 = x1 * (sc1 + 1.0f) + sh1;
        u32x4 w; w.x = pk2(u0[0], u0[1]); w.y = pk2(u0[2], u0[3]); w.z = pk2(u1[0], u1[1]); w.w = pk2(u1[2], u1[3]);
        *(u32x4*)(U + (size_t)row * D + c8) = w;
    }
}

__device__ __forceinline__ void phase_merge(const Params& p, int bid, int G) {
    const bf16_t* og = (const bf16_t*)(p.ws + WS_OG); const float* lse = (const float*)(p.ws + WS_LSE); bf16_t* oa = (bf16_t*)(p.ws + WS_OATT);
    const int nthr = G * 512;
    for (int i = bid * 512 + opaque_tid(); i < MC * AOUT / 8; i += nthr) {
        const int row = i >> 6, c8 = (i & 63) * 8, h = c8 >> 6;
        const float l0 = lse[(size_t)row * 8 + h], l1 = lse[(size_t)(MC + row) * 8 + h], l2 = lse[(size_t)(2 * MC + row) * 8 + h];
        const float mx = fmaxf(l0, fmaxf(l1, l2));
        float w0 = __expf(l0 - mx), w1 = __expf(l1 - mx), w2 = __expf(l2 - mx);
        const float inv = 1.0f / (w0 + w1 + w2); w0 *= inv; w1 *= inv; w2 *= inv;
        const u32x4 a = *(const u32x4*)(og + (size_t)row * AOUT + c8), b = *(const u32x4*)(og + (size_t)(MC + row) * AOUT + c8), c = *(const u32x4*)(og + (size_t)(2 * MC + row) * AOUT + c8);
        u32x4 o;
        o.x = pk2(w0 * bflo(a.x) + w1 * bflo(b.x) + w2 * bflo(c.x), w0 * bfhi(a.x) + w1 * bfhi(b.x) + w2 * bfhi(c.x));
        o.y = pk2(w0 * bflo(a.y) + w1 * bflo(b.y) + w2 * bflo(c.y), w0 * bfhi(a.y) + w1 * bfhi(b.y) + w2 * bfhi(c.y));
        o.z = pk2(w0 * bflo(a.z) + w1 * bflo(b.z) + w2 * bflo(c.z), w0 * bfhi(a.z) + w1 * bfhi(b.z) + w2 * bfhi(c.z));
        o.w = pk2(w0 * bflo(a.w) + w1 * bflo(b.w) + w2 * bflo(c.w), w0 * bfhi(a.w) + w1 * bfhi(b.w) + w2 * bfhi(c.w));
        *(u32x4*)(oa + (size_t)row * AOUT + c8) = o;
    }
}

template <bool SECOND>
__device__ __forceinline__ void phase_ln(const Params& p, int chunk, int bid, int G) {
    const int tid_ = opaque_tid(); const int lane = tid_ & 63, wave = tid_ >> 6;
    float* R = p.out + (size_t)chunk * MC * D;
    const float* gam = p.in[SECOND ? I_LN2G : I_LN1G]; const float* bet = p.in[SECOND ? I_LN2B : I_LN1B];
    const float* mod = (const float*)(p.ws + WS_MOD) + (size_t)chunk * CB * MOD6;
    float* X1 = (float*)(p.ws + WS_X1); bf16_t* U = (bf16_t*)(p.ws + WS_U);
    for (int row = bid * 8 + wave; row < MC; row += G * 8) {
        const f32x4* xr = (const f32x4*)(R + (size_t)row * D) + lane;
        f32x4 v[4]; float s = 0.f;
#pragma unroll
        for (int j = 0; j < 4; ++j) { v[j] = xr[64 * j]; s += (v[j].x + v[j].y) + (v[j].z + v[j].w); }
        const float mean = wave_sum(s) * (1.f / D); float s2 = 0.f;
#pragma unroll
        for (int j = 0; j < 4; ++j) { v[j] = v[j] - mean; s2 += (v[j].x * v[j].x + v[j].y * v[j].y) + (v[j].z * v[j].z + v[j].w * v[j].w); }
        const float rstd = rsqrtf(wave_sum(s2) * (1.f / D) + LN_EPS);
        const int b = row >> 11;
#pragma unroll
        for (int j = 0; j < 4; ++j) { const int c = 4 * lane + 256 * j;
            const f32x4 gg = *(const f32x4*)(gam + c), bb = *(const f32x4*)(bet + c);
            const f32x4 y = v[j] * rstd * gg + bb;
            if (SECOND) { *(f32x4*)(R + (size_t)row * D + c) = y; }
            else {
                *(f32x4*)(X1 + (size_t)row * D + c) = y;
                const float* mp = mod + (size_t)b * MOD6 + c;
                const f32x4 sh = *(const f32x4*)(mp + 3 * D), sc = *(const f32x4*)(mp + 4 * D);
                const f32x4 u = y * (sc + 1.0f) + sh;
                u32x2 w; w.x = pk2(u[0], u[1]); w.y = pk2(u[2], u[3]);
                *(u32x2*)(U + (size_t)row * D + c) = w; }
        }
    }
}

__device__ __forceinline__ void phase_convgate(const Params& p, int bid, int G) {
    const bf16_t* up = (const bf16_t*)(p.ws + WS_UP); bf16_t* act = (bf16_t*)(p.ws + WS_ACT);
    const float* cw = p.in[I_FCW]; const float* cb = p.in[I_FCB];
    const int nthr = G * 512;
    for (int i = bid * 512 + opaque_tid(); i < MC * FF / 8; i += nthr) {
        const int row = i / (FF / 8), c8 = (i % (FF / 8)) * 8, t = row & (SEQ - 1);
        float val[8], gt[8];
#pragma unroll
        for (int e = 0; e < 8; ++e) { val[e] = cb[c8 + e]; gt[e] = cb[FF + c8 + e]; }
#pragma unroll
        for (int k = 0; k < 3; ++k) {
            if (t - 2 + k < 0) continue;
            const bf16_t* rp = up + (size_t)(row - 2 + k) * FF2 + c8;
            const u32x4 a = *(const u32x4*)rp, b = *(const u32x4*)(rp + FF);
            const f32x4 wa0 = *(const f32x4*)(cw + k * FF2 + c8), wa1 = *(const f32x4*)(cw + k * FF2 + c8 + 4);
            const f32x4 wb0 = *(const f32x4*)(cw + k * FF2 + FF + c8), wb1 = *(const f32x4*)(cw + k * FF2 + FF + c8 + 4);
            val[0] += wa0[0] * bflo(a.x); val[1] += wa0[1] * bfhi(a.x); val[2] += wa0[2] * bflo(a.y); val[3] += wa0[3] * bfhi(a.y);
            val[4] += wa1[0] * bflo(a.z); val[5] += wa1[1] * bfhi(a.z); val[6] += wa1[2] * bflo(a.w); val[7] += wa1[3] * bfhi(a.w);
            gt[0] += wb0[0] * bflo(b.x); gt[1] += wb0[1] * bfhi(b.x); gt[2] += wb0[2] * bflo(b.y); gt[3] += wb0[3] * bfhi(b.y);
            gt[4] += wb1[0] * bflo(b.z); gt[5] += wb1[1] * bfhi(b.z); gt[6] += wb1[2] * bflo(b.w); gt[7] += wb1[3] * bfhi(b.w);
        }
        u32x4 o;
        o.x = pk2(gelu_tanh(gt[0]) * val[0], gelu_tanh(gt[1]) * val[1]); o.y = pk2(gelu_tanh(gt[2]) * val[2], gelu_tanh(gt[3]) * val[3]);
        o.z = pk2(gelu_tanh(gt[4]) * val[4], gelu_tanh(gt[5]) * val[5]); o.w = pk2(gelu_tanh(gt[6]) * val[6], gelu_tanh(gt[7]) * val[7]);
        *(u32x4*)(act + (size_t)row * FF + c8) = o;
    }
}

typedef short v4i16_t __attribute__((ext_vector_type(4)));
__device__ __forceinline__ s16x4 vtr(const unsigned char* pp) { return __builtin_bit_cast(s16x4, __builtin_amdgcn_ds_read_tr16_b64_v4i16((LAS v4i16_t*)(LAS unsigned char*)pp)); }

__device__ __forceinline__ void attn_item(const Params& p, unsigned char* smem, int item) {
    const int tid = opaque_tid(), lane = tid & 63, w = tid >> 6, fr = lane & 15, fq = lane >> 4;
    const int sub = item & 15, bgh = item >> 4, h = bgh & 7, bg = bgh >> 3, g = bg % 3, b = bg / 3;
    int d, r, n; if (g == 0) { d = 1; r = 0; n = sub; } else if (g == 1) { d = 4; r = sub >> 2; n = sub & 3; } else { d = 16; r = sub; n = 0; }
    const int hc = (g * 8 + h) * 64;
    const bf16_t* pb = (const bf16_t*)(p.ws + WS_PROJ) + (size_t)b * SEQ * INC;
    unsigned char* Ks = smem; unsigned char* Vs = smem + 36864; float* tb = (float*)(smem + 73728);
    for (int i = tid; i < 2048; i += 512) { const int j = i >> 3, ch = i & 7;
        u32x4 kv = (u32x4){0u, 0u, 0u, 0u}, vv = (u32x4){0u, 0u, 0u, 0u};
        if (n > 0 || j >= 128) { const int tok = ((n - 1) * 128 + j) * d + r; const bf16_t* q = pb + (size_t)tok * INC + hc + ch * 8; kv = *(const u32x4*)(q + OFF_K); vv = *(const u32x4*)(q + OFF_V); }
        *(u32x4*)(Ks + j * 144 + ch * 16) = kv; *(u32x4*)(Vs + j * 144 + ch * 16) = vv; }
    if (tid < 129) { const int dist = tid * d; int bucket;
        if (dist < 16) bucket = dist; else { const float nf = (float)dist; int lg = 16 + (int)(logf(nf / 16.0f) / 4.852030263919617f * 16.0f); bucket = lg < 31 ? lg : 31; }
        tb[tid] = p.in[I_RELB][bucket * 24 + g * 8 + h]; }
    __syncthreads();
    const int qi = 16 * w + fr, qtok = (n * 128 + qi) * d + r;
    const bf16_t* qp = pb + (size_t)qtok * INC + hc + fq * 8;
    const bf16x8 qf0 = *(const bf16x8*)qp, qf1 = *(const bf16x8*)(qp + 32);
    f32x4 s[9];
#pragma unroll
    for (int t = 0; t < 9; ++t) { const unsigned char* kp = Ks + (16 * (w + t) + fr) * 144 + fq * 16;
        const bf16x8 k0 = *(const bf16x8*)kp, k1 = *(const bf16x8*)(kp + 64);
        f32x4 a = (f32x4){0.f, 0.f, 0.f, 0.f};
        a = __builtin_amdgcn_mfma_f32_16x16x32_bf16(k0, qf0, a, 0, 0, 0);
        a = __builtin_amdgcn_mfma_f32_16x16x32_bf16(k1, qf1, a, 0, 0, 0);
        s[t] = a; }
    float mx = -1e30f;
#pragma unroll
    for (int t = 0; t < 9; ++t)
#pragma unroll
        for (int e = 0; e < 4; ++e) { const int dist = fr + 128 - 16 * t - 4 * fq - e; const int j = 16 * (w + t) + 4 * fq + e;
            const bool ok = (dist >= 0) && (dist <= 128) && (n > 0 || j >= 128);
            const float lg = ok ? s[t][e] * 0.125f + tb[ok ? dist : 0] : -1e30f; s[t][e] = lg; mx = fmaxf(mx, lg); }
    mx = fmaxf(mx, __shfl_xor(mx, 16)); mx = fmaxf(mx, __shfl_xor(mx, 32));
    float sum = 0.f;
#pragma unroll
    for (int t = 0; t < 9; ++t)
#pragma unroll
        for (int e = 0; e < 4; ++e) { const float pv = __expf(s[t][e] - mx); s[t][e] = pv; sum += pv; }
    sum += __shfl_xor(sum, 16); sum += __shfl_xor(sum, 32);
    f32x4 o[4];
#pragma unroll
    for (int mt = 0; mt < 4; ++mt) o[mt] = (f32x4){0.f, 0.f, 0.f, 0.f};
#pragma unroll
    for (int pp = 0; pp < 5; ++pp) { const int tA = 2 * pp, tB = (2 * pp + 1 < 9) ? 2 * pp + 1 : 2 * pp;
        u32x4 pw; pw.x = pk2(s[tA][0], s[tA][1]); pw.y = pk2(s[tA][2], s[tA][3]);
        if (2 * pp + 1 < 9) { pw.z = pk2(s[tB][0], s[tB][1]); pw.w = pk2(s[tB][2], s[tB][3]); } else { pw.z = 0u; pw.w = 0u; }
        const bf16x8 pf = __builtin_bit_cast(bf16x8, pw);
        const unsigned char* va = Vs + (16 * (w + tA) + 4 * fq + (fr >> 2)) * 144 + 8 * (fr & 3);
        const unsigned char* vb = Vs + (16 * (w + tB) + 4 * fq + (fr >> 2)) * 144 + 8 * (fr & 3);
#pragma unroll
        for (int mt = 0; mt < 4; ++mt) { const s16x4 lo = vtr(va + 32 * mt), hi = vtr(vb + 32 * mt);
            bf16x8 vf; vf[0] = lo[0]; vf[1] = lo[1]; vf[2] = lo[2]; vf[3] = lo[3]; vf[4] = hi[0]; vf[5] = hi[1]; vf[6] = hi[2]; vf[7] = hi[3];
            o[mt] = __builtin_amdgcn_mfma_f32_16x16x32_bf16(vf, pf, o[mt], 0, 0, 0); } }
    const float inv = 1.0f / sum;
    const size_t orow = (size_t)g * MC + (size_t)b * SEQ + qtok;
    bf16_t* op = (bf16_t*)(p.ws + WS_OG) + orow * AOUT + h * 64 + 4 * fq;
#pragma unroll
    for (int mt = 0; mt < 4; ++mt) { u32x2 wv; wv.x = pk2(o[mt][0] * inv, o[mt][1] * inv); wv.y = pk2(o[mt][2] * inv, o[mt][3] * inv); *(u32x2*)(op + 16 * mt) = wv; }
    if (fq == 0) ((float*)(p.ws + WS_LSE))[orow * 8 + h] = mx + __logf(sum);
}

__device__ __forceinline__ void lru_item(const Params& p, unsigned char* smem, int item) {
    const int tid = opaque_tid(), lane = tid & 63, w = tid >> 6, fr = lane & 15, fq = lane >> 4;
    const int b = item >> 4, nb = item & 15, ch0 = nb * 64;
    const bf16_t* pb = (const bf16_t*)(p.ws + WS_PROJ) + (size_t)b * SEQ * INC;
    bf16_t* hgp = (bf16_t*)(p.ws + WS_HG) + (size_t)b * SEQ * D + ch0;
    unsigned char* XR = smem;
    unsigned char* WL = smem + 18432;
    float* LA = (float*)(smem + 36864);
    float* LB = (float*)(smem + 69632);
    float* CW = (float*)(smem + 102400);
    float* CBI = CW + 256; float* BA = CW + 320; float* BX = CW + 384; float* SP = CW + 448;
    float* SEG = CW + 512;
    float* CIN = CW + 1536;
    if (tid < 256) CW[tid] = p.in[I_LCW][(tid >> 6) * D + ch0 + (tid & 63)];
    else if (tid < 320) { const int c = tid - 256; CBI[c] = p.in[I_LCB][ch0 + c]; BA[c] = p.in[I_LBA][ch0 + c]; BX[c] = p.in[I_LBX][ch0 + c]; SP[c] = log1pf(__expf(-p.in[I_LLAM][ch0 + c])); }
    { const bf16_t* wl = (const bf16_t*)(p.ws + WS_WLRU);
      for (int i = tid; i < 1024; i += 512) { const int gsel = i >> 9, rr = (i >> 3) & 63, ch = i & 7;
          *(u32x4*)(WL + gsel * 9216 + rr * 144 + ch * 16) = *(const u32x4*)(wl + gsel * 65536 + nb * 4096 + rr * 64 + ch * 8); } }
    float hprev = 0.f;
    const int tt = tid >> 2, c0 = (tid & 3) * 16;
    for (int seg = 0; seg < SEQ / 128; ++seg) {
        const int t0 = seg * 128;
        __syncthreads();
        {
            float xr[16];
#pragma unroll
            for (int e = 0; e < 16; ++e) xr[e] = CBI[c0 + e];
#pragma unroll
            for (int k = 0; k < 4; ++k) { const int t = t0 + tt - 3 + k;
                if (t >= 0) { const bf16_t* xp = pb + (size_t)t * INC + OFF_XL + ch0 + c0;
                    const u32x4 a = *(const u32x4*)xp, bq = *(const u32x4*)(xp + 8);
                    const float* cw = CW + k * 64 + c0;
                    xr[0] += cw[0] * bflo(a.x); xr[1] += cw[1] * bfhi(a.x); xr[2] += cw[2] * bflo(a.y); xr[3] += cw[3] * bfhi(a.y);
                    xr[4] += cw[4] * bflo(a.z); xr[5] += cw[5] * bfhi(a.z); xr[6] += cw[6] * bflo(a.w); xr[7] += cw[7] * bfhi(a.w);
                    xr[8] += cw[8] * bflo(bq.x); xr[9] += cw[9] * bfhi(bq.x); xr[10] += cw[10] * bflo(bq.y); xr[11] += cw[11] * bfhi(bq.y);
                    xr[12] += cw[12] * bflo(bq.z); xr[13] += cw[13] * bfhi(bq.z); xr[14] += cw[14] * bflo(bq.w); xr[15] += cw[15] * bfhi(bq.w); } }
            u32x4 w0, w1; w0.x = pk2(xr[0], xr[1]); w0.y = pk2(xr[2], xr[3]); w0.z = pk2(xr[4], xr[5]); w0.w = pk2(xr[6], xr[7]);
            w1.x = pk2(xr[8], xr[9]); w1.y = pk2(xr[10], xr[11]); w1.z = pk2(xr[12], xr[13]); w1.w = pk2(xr[14], xr[15]);
            *(u32x4*)(XR + tt * 144 + c0 * 2) = w0; *(u32x4*)(XR + tt * 144 + c0 * 2 + 16) = w1;
#pragma unroll
            for (int q = 0; q < 4; ++q) *(f32x4*)(LB + tt * 64 + c0 + 4 * q) = (f32x4){xr[4 * q], xr[4 * q + 1], xr[4 * q + 2], xr[4 * q + 3]};
        }
        __syncthreads();
        {
            const unsigned char* ap = XR + (16 * w + fr) * 144 + fq * 16;
            const bf16x8 a0 = *(const bf16x8*)ap, a1 = *(const bf16x8*)(ap + 64);
#pragma unroll
            for (int nt = 0; nt < 4; ++nt) {
                const unsigned char* bp = WL + (16 * nt + fr) * 144 + fq * 16;
                const bf16x8 ba0 = *(const bf16x8*)bp, ba1 = *(const bf16x8*)(bp + 64), bx0 = *(const bf16x8*)(bp + 9216), bx1 = *(const bf16x8*)(bp + 9216 + 64);
                f32x4 ar = (f32x4){0.f, 0.f, 0.f, 0.f}, ax = (f32x4){0.f, 0.f, 0.f, 0.f};
                ar = __builtin_amdgcn_mfma_f32_16x16x32_bf16(a0, ba0, ar, 0, 0, 0); ar = __builtin_amdgcn_mfma_f32_16x16x32_bf16(a1, ba1, ar, 0, 0, 0);
                ax = __builtin_amdgcn_mfma_f32_16x16x32_bf16(a0, bx0, ax, 0, 0, 0); ax = __builtin_amdgcn_mfma_f32_16x16x32_bf16(a1, bx1, ax, 0, 0, 0);
                const int dch = 16 * nt + fr; const float bav = BA[dch], bxv = BX[dch], spv = SP[dch];
#pragma unroll
                for (int e = 0; e < 4; ++e) { const int t = 16 * w + 4 * fq + e;
                    const float rr = sigmoidf_(ar[e] + bav), ii = sigmoidf_(ax[e] + bxv);
                    const float la = -8.0f * rr * spv; const float av = __expf(la);
                    const float xv = LB[t * 64 + dch];
                    LA[t * 64 + dch] = av; LB[t * 64 + dch] = sqrtf(-expm1f(2.0f * la)) * (ii * xv); }
            }
        }
        __syncthreads();
        {
            float hh = 0.f, AA = 1.f;
#pragma unroll
            for (int i = 0; i < 16; ++i) { const int idx = (16 * w + i) * 64 + lane; const float av = LA[idx], bv = LB[idx]; hh = av * hh + bv; AA *= av; LB[idx] = hh; LA[idx] = AA; }
            SEG[(w * 64 + lane) * 2] = AA; SEG[(w * 64 + lane) * 2 + 1] = hh;
        }
        __syncthreads();
        {
            float cin = hprev, mine = 0.f;
#pragma unroll
            for (int s2 = 0; s2 < 8; ++s2) { if (s2 == w) mine = cin; cin = SEG[(s2 * 64 + lane) * 2] * cin + SEG[(s2 * 64 + lane) * 2 + 1]; }
            hprev = cin; CIN[w * 64 + lane] = mine;
        }
        __syncthreads();
        {
            const int s2 = tt >> 4; const int t = t0 + tt;
            const bf16_t* gp = pb + (size_t)t * INC + OFF_LG + ch0 + c0;
            const u32x4 g0 = *(const u32x4*)gp, g1 = *(const u32x4*)(gp + 8);
            float hv[16];
#pragma unroll
            for (int q = 0; q < 4; ++q) { const f32x4 lb = *(const f32x4*)(LB + tt * 64 + c0 + 4 * q), la = *(const f32x4*)(LA + tt * 64 + c0 + 4 * q), ci = *(const f32x4*)(CIN + s2 * 64 + c0 + 4 * q);
                const f32x4 hq = lb + la * ci; hv[4 * q] = hq[0]; hv[4 * q + 1] = hq[1]; hv[4 * q + 2] = hq[2]; hv[4 * q + 3] = hq[3]; }
            u32x4 o0, o1;
            o0.x = pk2(hv[0] * gelu_tanh(bflo(g0.x)), hv[1] * gelu_tanh(bfhi(g0.x))); o0.y = pk2(hv[2] * gelu_tanh(bflo(g0.y)), hv[3] * gelu_tanh(bfhi(g0.y)));
            o0.z = pk2(hv[4] * gelu_tanh(bflo(g0.z)), hv[5] * gelu_tanh(bfhi(g0.z))); o0.w = pk2(hv[6] * gelu_tanh(bflo(g0.w)), hv[7] * gelu_tanh(bfhi(g0.w)));
            o1.x = pk2(hv[8] * gelu_tanh(bflo(g1.x)), hv[9] * gelu_tanh(bfhi(g1.x))); o1.y = pk2(hv[10] * gelu_tanh(bflo(g1.y)), hv[11] * gelu_tanh(bfhi(g1.y)));
            o1.z = pk2(hv[12] * gelu_tanh(bflo(g1.z)), hv[13] * gelu_tanh(bfhi(g1.z))); o1.w = pk2(hv[14] * gelu_tanh(bflo(g1.w)), hv[15] * gelu_tanh(bfhi(g1.w)));
            *(u32x4*)(hgp + (size_t)t * D + c0) = o0; *(u32x4*)(hgp + (size_t)t * D + c0 + 8) = o1;
        }
    }
}

constexpr int N_LRU_ITEMS = CB * 16, N_ATT_ITEMS = CB * 384;
__device__ __forceinline__ void phase_mix(const Params& p, unsigned char* smem, unsigned* ctr) {
    int* slot = (int*)(smem + LDS_BYTES - 16);
    for (int item = blockIdx.x;; item += gridDim.x) {
        __syncthreads();
        if (item >= N_LRU_ITEMS + N_ATT_ITEMS) break;
        if (item < N_LRU_ITEMS) lru_item(p, smem, item); else attn_item(p, smem, item - N_LRU_ITEMS);
    }
}

__device__ __forceinline__ void grid_barrier(unsigned* bar, unsigned target) {
    asm volatile("s_waitcnt vmcnt(0)" ::: "memory");
    __syncthreads();
    if (threadIdx.x == 0) {
        __builtin_amdgcn_fence(__ATOMIC_RELEASE, "agent");
        asm volatile("s_waitcnt vmcnt(0)" ::: "memory");
        __hip_atomic_fetch_add(bar, 1u, __ATOMIC_RELAXED, __HIP_MEMORY_SCOPE_AGENT);
        unsigned spins = 0;
        while (__hip_atomic_load(bar, __ATOMIC_RELAXED, __HIP_MEMORY_SCOPE_AGENT) < target) { __builtin_amdgcn_s_sleep(1); if (++spins > (1u << 26)) break; }
        __builtin_amdgcn_fence(__ATOMIC_ACQUIRE, "agent");
        asm volatile("s_waitcnt vmcnt(0)" ::: "memory");
    }
    __syncthreads();
}

__global__ void __launch_bounds__(512, 2) mega_fwd(Params p) {
    extern __shared__ __attribute__((aligned(16))) unsigned char smem[];
    cg::grid_group grid = cg::this_grid();
    const int G = gridDim.x, bid = blockIdx.x;
    LAS unsigned char* lds = (LAS unsigned char*)smem;
    unsigned char* ws = p.ws;
    unsigned* ctl = (unsigned*)(ws + WS_CTL);

    unsigned nbar = 0;
#define GSYNC() do { asm volatile("s_waitcnt vmcnt(0)" ::: "memory"); grid.sync(); } while (0)
    grid.sync();
    phase0(p, smem, bid, G);
    GSYNC();
#pragma unroll 1
    for (int ch = 0; ch < NCH; ++ch) {
        const float* mod = (const float*)(ws + WS_MOD) + (size_t)ch * CB * MOD6;
        phase_modx(p, ch, bid, G);
        GSYNC();
        {
            pg8::Gemm g{(const bf16_t*)(ws + WS_U), (const bf16_t*)(ws + WS_WIN), MC, INC, D, D}; pg8::StaticOrder S; S.init(MC, INC, G, bid);
            pg8::EpiBf<0> E{(bf16_t*)(ws + WS_PROJ), INC, nullptr, 0, nullptr};
            pg8::gemm_phase<pg8::EpiBf<0>, pg8::StaticOrder, true, true>(lds, g, S, E);
        }
        GSYNC();
#if PROBE == 1
        {   const bf16_t* pr = (const bf16_t*)(ws + WS_PROJ); float* o = p.out + (size_t)ch * MC * D;
            for (int i = bid * 512 + opaque_tid(); i < MC * D; i += G * 512) { const int row = i >> 10, c = i & 1023; o[i] = bflo(pr[(size_t)row * INC + c + 1024 * (row & 7) + 512 * ((row >> 3) & 1)]); }
            continue; }
#endif
        phase_mix(p, smem, ctl + 64 * ch);
        GSYNC();
        phase_merge(p, bid, G);
        GSYNC();
#if PROBE == 2
        {   const bf16_t* oa = (const bf16_t*)(ws + WS_OATT); const bf16_t* hg = (const bf16_t*)(ws + WS_HG); float* o = p.out + (size_t)ch * MC * D;
            for (int i = bid * 512 + opaque_tid(); i < MC * D; i += G * 512) { const int row = i >> 10, c = i & 1023; o[i] = bflo(hg[(size_t)row * D + c]); }
            continue; }
#endif
        {
            pg8::Gemm g{(const bf16_t*)(ws + WS_OATT), (const bf16_t*)(ws + WS_WPA), MC, D, AOUT, AOUT}; pg8::StaticOrder S; S.init(MC, D, G, bid);
            pg8::EpiBf<1> E{(bf16_t*)(ws + WS_YAG), D, (const bf16_t*)(ws + WS_PROJ) + OFF_GA, INC, nullptr};
            pg8::gemm_phase<pg8::EpiBf<1>, pg8::StaticOrder, true, true>(lds, g, S, E);
        }
        GSYNC();
        {
            pg8::Gemm g{(const bf16_t*)(ws + WS_HG), (const bf16_t*)(ws + WS_WPL), MC, D, D, D}; pg8::StaticOrder S; S.init(MC, D, G, bid);
            pg8::EpiBf<2> E{(bf16_t*)(ws + WS_MRG), D, (const bf16_t*)(ws + WS_PROJ) + OFF_GR, INC, (const bf16_t*)(ws + WS_YAG)};
            pg8::gemm_phase<pg8::EpiBf<2>, pg8::StaticOrder, true, true>(lds, g, S, E);
        }
        GSYNC();
        {
            pg8::Gemm g{(const bf16_t*)(ws + WS_MRG), (const bf16_t*)(ws + WS_WOUT), MC, D, D, D}; pg8::StaticOrder S; S.init(MC, D, G, bid);
            pg8::EpiResid E{p.out + (size_t)ch * MC * D, p.in[I_X] + (size_t)ch * MC * D, mod + 2 * D};
            pg8::gemm_phase<pg8::EpiResid, pg8::StaticOrder, true, true>(lds, g, S, E);
        }
        GSYNC();
        phase_ln<false>(p, ch, bid, G);
        GSYNC();
        {
            pg8::Gemm g{(const bf16_t*)(ws + WS_U), (const bf16_t*)(ws + WS_WUP), MC, FF2, D, D}; pg8::StaticOrder S; S.init(MC, FF2, G, bid);
            pg8::EpiBf<0> E{(bf16_t*)(ws + WS_UP), FF2, nullptr, 0, nullptr};
            pg8::gemm_phase<pg8::EpiBf<0>, pg8::StaticOrder, true, true>(lds, g, S, E);
        }
        GSYNC();
        phase_convgate(p, bid, G);
        GSYNC();
        {
            pg8::Gemm g{(const bf16_t*)(ws + WS_ACT), (const bf16_t*)(ws + WS_WDN), MC, D, FF, FF}; pg8::StaticOrder S; S.init(MC, D, G, bid);
            pg8::EpiResid E{p.out + (size_t)ch * MC * D, (const float*)(ws + WS_X1), mod + 5 * D};
            pg8::gemm_phase<pg8::EpiResid, pg8::StaticOrder, true, true>(lds, g, S, E);
        }
        GSYNC();
        phase_ln<true>(p, ch, bid, G);
    }
}

extern "C" void kernel_launch(void* const* d_in, const int* in_sizes, int n_in, void* d_out, int out_size, void* d_ws, size_t ws_size, hipStream_t stream) {
    static int grid = 0;
    if (grid == 0) {
        int dev = 0, cus = 0, per_cu = 0;
        (void)hipGetDevice(&dev);
        (void)hipDeviceGetAttribute(&cus, hipDeviceAttributeMultiprocessorCount, dev);
        if (hipFuncSetAttribute((const void*)mega_fwd, hipFuncAttributeMaxDynamicSharedMemorySize, LDS_BYTES) != hipSuccess) fprintf(stderr, "kernel_launch: hipFuncSetAttribute failed\n");
        if (hipOccupancyMaxActiveBlocksPerMultiprocessor(&per_cu, (const void*)mega_fwd, 512, LDS_BYTES) != hipSuccess || per_cu < 1) { fprintf(stderr, "kernel_launch: occupancy query says %d\n", per_cu); per_cu = 1; }
        (void)hipGetLastError();
        grid = cus * per_cu;
        if (n_in != 24 || ws_size < WS_END) fprintf(stderr, "kernel_launch: unexpected n_in %d / ws_size %zu (need %zu)\n", n_in, ws_size, (size_t)WS_END);
    }
    (void)hipMemsetAsync((char*)d_ws + WS_CTL, 0, CTL_BYTES, stream);
    Params p{};
    for (int i = 0; i < 24; ++i) p.in[i] = (const float*)d_in[i];
    p.out = (float*)d_out; p.ws = (unsigned char*)d_ws;
    void* args[] = {&p};
    hipError_t e = hipLaunchCooperativeKernel((const void*)mega_fwd, dim3(grid), dim3(512), args, LDS_BYTES, stream);
    if (e != hipSuccess) fprintf(stderr, "kernel_launch: cooperative launch failed: %s (grid %d)\n", hipGetErrorString(e), grid);
}
```

```cpp
#include <hip/hip_runtime.h>
#include <hip/hip_cooperative_groups.h>
#include <cstdio>
#include <cstdint>
namespace cg = cooperative_groups;

#define LAS __attribute__((address_space(3)))
typedef unsigned short bf16_t;
typedef short bf16x8 __attribute__((ext_vector_type(8)));
typedef short s16x4 __attribute__((ext_vector_type(4)));
typedef float f32x4 __attribute__((ext_vector_type(4)));
typedef unsigned u32x4 __attribute__((ext_vector_type(4)));
typedef unsigned u32x2 __attribute__((ext_vector_type(2)));

constexpr int D = 1024, NB = 32, SEQ = 2048, MTOT = NB * SEQ;
constexpr int QKV = 1536, INC = 8704, FF = 3072, FF2 = 6144, AOUT = 512;
constexpr int OFF_Q = 0, OFF_K = 1536, OFF_V = 3072, OFF_XL = 4608, OFF_LG = 5632, OFF_GA = 6656, OFF_GR = 7680;
constexpr int CB = 16;
constexpr int MC = CB * SEQ;
constexpr int NCH = NB / CB;
constexpr float ALPHA = 1.189207115002721f;
constexpr float LN_EPS = 1e-5f;
constexpr int MOD6 = 6 * D;
constexpr int K2 = AOUT + D;

constexpr size_t MiB = 1u << 20;
constexpr size_t WS_CTL = 0, CTL_BYTES = 64 * 1024;
constexpr size_t WS_MOD = 1 * MiB;
constexpr size_t WS_WIN = 2 * MiB;
constexpr size_t WS_WPA = WS_WIN + (size_t)INC * D * 2;
constexpr size_t WS_WPL = WS_WPA + (size_t)D * AOUT * 2;
constexpr size_t WS_WOUT = WS_WPL + (size_t)D * D * 2;
constexpr size_t WS_WUP = WS_WOUT + (size_t)D * D * 2;
constexpr size_t WS_WDN = WS_WUP + (size_t)FF2 * D * 2;
constexpr size_t WS_WLRU = WS_WDN + (size_t)D * FF * 2;
constexpr size_t WS_WEND = WS_WLRU + 2 * 16 * 64 * 64 * 2;
static_assert(WS_WEND <= 50 * MiB, "weights region");
constexpr size_t WS_U = 50 * MiB;
constexpr size_t WS_PROJ = WS_U + (size_t)MC * D * 2;
constexpr size_t WS_OG = WS_PROJ + (size_t)MC * INC * 2;
constexpr size_t WS_LSE = WS_OG + (size_t)3 * MC * AOUT * 2;
constexpr size_t WS_OATT = WS_LSE + (size_t)3 * MC * 8 * 4;
constexpr size_t WS_HG = WS_OATT + (size_t)MC * AOUT * 2;
constexpr size_t WS_YAG = WS_HG + (size_t)MC * D * 2;
constexpr size_t WS_MRG = WS_YAG + (size_t)MC * D * 2;
constexpr size_t WS_END = WS_MRG + (size_t)MC * D * 2;
constexpr size_t WS_UP = WS_PROJ;
constexpr size_t WS_ACT = WS_UP + (size_t)MC * FF2 * 2;
static_assert(WS_ACT + (size_t)MC * FF * 2 <= WS_LSE, "UP|ACT overlay must stay inside PROJ|OG");
static_assert(WS_END <= 1024 * MiB, "workspace");

constexpr int LDS_BYTES = 147456;
#ifndef TIMECAT
#define TIMECAT 0
#endif

__device__ __forceinline__ unsigned f2bf(float f) { unsigned u = __builtin_bit_cast(unsigned, f); return (u + 0x7fffu + ((u >> 16) & 1u)) >> 16; }
__device__ __forceinline__ unsigned pk2(float lo, float hi) { unsigned r; asm("v_cvt_pk_bf16_f32 %0, %1, %2" : "=v"(r) : "v"(lo), "v"(hi)); return r; }
__device__ __forceinline__ int opaque_tid() { int t = threadIdx.x; asm volatile("" : "+v"(t)); return t; }
__device__ __forceinline__ float bflo(unsigned u) { return __builtin_bit_cast(float, u << 16); }
__device__ __forceinline__ float bfhi(unsigned u) { return __builtin_bit_cast(float, u & 0xffff0000u); }
__device__ __forceinline__ float sigmoidf_(float x) { return __builtin_amdgcn_rcpf(1.0f + __expf(-x)); }
__device__ __forceinline__ float gelu_tanh(float x) { const float u = 1.5957691216057308f * (x + 0.044715f * x * x * x); return x * sigmoidf_(u); }
__device__ __forceinline__ float wave_sum(float v) {
#pragma unroll
    for (int o = 1; o < 64; o <<= 1) v += __shfl_xor(v, o);
    return v;
}

namespace pg8 {
constexpr int BM = 256, BK = 64, HALF = 128, HTB = HALF * BK * 2, STAGE_BYTES = 8 * HTB, NXCD = 8, WGM = 8;
__host__ __device__ __forceinline__ int lds_byte(int r, int c) { const int st = (r >> 4) * 2 + (c >> 5), rr = r & 15, cc = c & 31, ob = rr * 64 + cc * 2; return st * 1024 + (ob ^ (((ob >> 9) & 1) << 5)); }
__host__ __device__ __forceinline__ void stage_rc(int b, int& R, int& C) { const int st = b / 1024, sb = b % 1024, swz = sb ^ (((sb >> 9) & 1) << 5); R = (st >> 1) * 16 + swz / 64; C = (st & 1) * 32 + (swz % 64) / 2; }
__host__ __device__ __forceinline__ int perm32(int rho) { const int n = rho >> 4, i = rho & 15; return 8 * (i >> 2) + 4 * n + (i & 3); }

struct Unit { int pm, pn; };
struct Gemm { const bf16_t* A; const bf16_t* Bt; int M, N, K, lda; };

struct StaticOrder {
    int nM, nN, nwg, G, c;
    __device__ void init(int M, int N, int G_, int c_) { nM = M / BM; nN = N / BM; nwg = nM * nN; G = G_; c = c_; }
    __device__ bool next(int i, Unit& u) const {
        const long L = (long)i * G + c; if (L >= nwg) return false;
        int wgid = (int)L; { const int q = nwg / NXCD, r = nwg % NXCD, xcd = wgid % NXCD, off = wgid / NXCD; wgid = (xcd < r ? xcd * (q + 1) : r * (q + 1) + (xcd - r) * q) + off; }
        const int nig = WGM * nN, gid = wgid / nig, fm = gid * WGM, gsz = (nM - fm) < WGM ? (nM - fm) : WGM;
        u.pm = fm + ((wgid % nig) % gsz); u.pn = (wgid % nig) / gsz; return true;
    }
};

template <class Epi, class Sched, bool ALIGN_EPI, bool SP2>
__device__ __forceinline__ void gemm_phase(LAS unsigned char* lds, const Gemm g, const Sched& S, const Epi& E) {
    const int tid = opaque_tid(), wid = __builtin_amdgcn_readfirstlane(tid >> 6), lane = tid & 63, wr = wid >> 2, wc = wid & 3, fr = lane & 15, fq = lane >> 4;
    const int K = g.K, nt = K / BK, lda = g.lda;
    unsigned voffA[2], voffB[2];
#pragma unroll
    for (int i = 0; i < 2; ++i) { int R, C; stage_rc(tid * 16 + i * 8192, R, C); const int Rb = Epi::PERM ? ((R & ~31) + perm32(R & 31)) : R;
        voffA[i] = (unsigned)(R * lda + C) * 2u; voffB[i] = (unsigned)(Rb * K + C) * 2u; }
    const size_t kstep = (size_t)(BK * 2);
    const size_t hstepA = (size_t)HALF * lda * 2, hstepB = (size_t)HALF * K * 2;
    const size_t tstepA = 2 * hstepA, tstepB = 2 * hstepB;
    const unsigned ldsw = (unsigned)wid * 1024u;
    const int aoff = lds_byte(wr * 64 + fr, fq * 8), boff = lds_byte(wc * 32 + fr, fq * 8);
#define PG8_SA(b, h) (((b) * 2 + (h)) * HTB)
#define PG8_SB(b, h) ((4 + (b) * 2 + (h)) * HTB)
#define PG8_STAGE(bufoff, gbase, voff) do { _Pragma("unroll") for (int _i = 0; _i < 2; ++_i) \
        __builtin_amdgcn_global_load_lds((const unsigned*)((const char*)(gbase) + (voff)[_i]), (LAS unsigned*)(lds + (bufoff) + ldsw + _i * 8192), 16, 0, 0); } while (0)
#define PG8_LDA(dst, b, h) do { _Pragma("unroll") for (int m = 0; m < 4; ++m) _Pragma("unroll") for (int k = 0; k < 2; ++k) dst[m][k] = *(const LAS bf16x8*)(lds + PG8_SA(b, h) + aoff + m * 2048 + k * 1024); } while (0)
#define PG8_LDB(dst, b, h) do { _Pragma("unroll") for (int n = 0; n < 2; ++n) _Pragma("unroll") for (int k = 0; k < 2; ++k) dst[n][k] = *(const LAS bf16x8*)(lds + PG8_SB(b, h) + boff + n * 2048 + k * 1024); } while (0)
#define PG8_MMA(ai, bj, At, Bt) do { __builtin_amdgcn_s_setprio(1); _Pragma("unroll") for (int m = 0; m < 4; ++m) _Pragma("unroll") for (int n = 0; n < 2; ++n) _Pragma("unroll") for (int k = 0; k < 2; ++k) \
        acc[ai][bj][m][n] = __builtin_amdgcn_mfma_f32_16x16x32_bf16(Bt[n][k], At[m][k], acc[ai][bj][m][n], 0, 0, 0); __builtin_amdgcn_s_setprio(0); } while (0)
#define PG8_WAIT_V(n) asm volatile("s_waitcnt vmcnt(" #n ")" ::: "memory")
#define PG8_WAIT_L(n) asm volatile("s_waitcnt lgkmcnt(" #n ")" ::: "memory")
#define PG8_BAR __builtin_amdgcn_s_barrier()
#define PG8_SCHED __builtin_amdgcn_sched_barrier(0)
    Unit cur, nxt; int ui = 0;
    if (!S.next(0, cur)) return;
    f32x4 acc[2][2][4][2];
#pragma unroll
    for (int a = 0; a < 2; ++a)
#pragma unroll
        for (int b = 0; b < 2; ++b)
#pragma unroll
            for (int m = 0; m < 4; ++m)
#pragma unroll
                for (int n = 0; n < 2; ++n) acc[a][b][m][n] = (f32x4){0.f, 0.f, 0.f, 0.f};
    bf16x8 At[4][2], B0[2][2], B1[2][2];
    const char* cA = (const char*)g.A + (size_t)cur.pm * tstepA; const char* cB = (const char*)g.Bt + (size_t)cur.pn * tstepB;
    if constexpr (SP2) {
        PG8_STAGE(PG8_SB(0, 0), cB, voffB); PG8_STAGE(PG8_SB(0, 1), cB + hstepB, voffB); PG8_STAGE(PG8_SA(0, 0), cA, voffA); PG8_STAGE(PG8_SA(0, 1), cA + hstepA, voffA);
        if (wr == 1) PG8_BAR;
        PG8_WAIT_V(2); PG8_BAR;
        PG8_STAGE(PG8_SB(1, 0), cB + kstep, voffB); PG8_STAGE(PG8_SA(1, 0), cA + kstep, voffA); PG8_STAGE(PG8_SB(1, 1), cB + hstepB + kstep, voffB);
        PG8_WAIT_V(6); PG8_BAR;
    } else {
        PG8_STAGE(PG8_SB(0, 0), cB, voffB); PG8_STAGE(PG8_SA(0, 0), cA, voffA); PG8_STAGE(PG8_SB(0, 1), cB + hstepB, voffB); PG8_STAGE(PG8_SA(0, 1), cA + hstepA, voffA);
        if (wr == 1) PG8_BAR;
        PG8_WAIT_V(4); PG8_BAR;
        PG8_STAGE(PG8_SB(1, 0), cB + kstep, voffB); PG8_STAGE(PG8_SA(1, 0), cA + kstep, voffA); PG8_STAGE(PG8_SB(1, 1), cB + hstepB + kstep, voffB);
        PG8_WAIT_V(6); PG8_BAR;
    }
    for (;;) {
        const bool has_next = S.next(ui + 1, nxt);
        const char* nA = has_next ? (const char*)g.A + (size_t)nxt.pm * tstepA : cA; const char* nB = has_next ? (const char*)g.Bt + (size_t)nxt.pn * tstepB : cB;
        for (int t = 0; t < nt; t += 2) {
            const bool last = (t == nt - 2);
            const char* a1 = cA + (size_t)(t + 1) * kstep;
            const char* a2 = last ? nA : cA + (size_t)(t + 2) * kstep; const char* b2 = last ? nB : cB + (size_t)(t + 2) * kstep;
            const char* a3 = a2 + kstep; const char* b3 = b2 + kstep;
            if constexpr (Epi::MID_T > 0) { if (t == Epi::MID_T) E.mid(acc, cur, wr, wc, fr, fq); }
            if constexpr (SP2) {
            PG8_LDB(B0, 0, 0); PG8_LDB(B1, 0, 1); PG8_SCHED; PG8_LDA(At, 0, 0); PG8_STAGE(PG8_SA(1, 1), a1 + hstepA, voffA);
            PG8_WAIT_V(8); PG8_WAIT_L(0); PG8_BAR; PG8_MMA(0, 0, At, B0); PG8_MMA(0, 1, At, B1); PG8_BAR; PG8_SCHED;
            PG8_LDA(At, 0, 1); PG8_STAGE(PG8_SB(0, 0), b2, voffB); PG8_STAGE(PG8_SB(0, 1), b2 + hstepB, voffB); PG8_STAGE(PG8_SA(0, 0), a2, voffA);
            PG8_WAIT_V(8); PG8_WAIT_L(0); PG8_BAR; PG8_MMA(1, 0, At, B0); PG8_MMA(1, 1, At, B1); PG8_BAR; PG8_SCHED;
            PG8_LDB(B0, 1, 0); PG8_LDB(B1, 1, 1); PG8_SCHED; PG8_LDA(At, 1, 0); PG8_STAGE(PG8_SA(0, 1), a2 + hstepA, voffA);
            PG8_WAIT_V(8); PG8_WAIT_L(0); PG8_BAR; PG8_MMA(0, 0, At, B0); PG8_MMA(0, 1, At, B1); PG8_BAR; PG8_SCHED;
            PG8_LDA(At, 1, 1); PG8_STAGE(PG8_SB(1, 0), b3, voffB); PG8_STAGE(PG8_SB(1, 1), b3 + hstepB, voffB); PG8_STAGE(PG8_SA(1, 0), a3, voffA);
            PG8_WAIT_V(8); PG8_WAIT_L(0); PG8_BAR; PG8_MMA(1, 0, At, B0); PG8_MMA(1, 1, At, B1); PG8_BAR; PG8_SCHED;
            } else {
            PG8_LDB(B0, 0, 0); PG8_SCHED; PG8_LDA(At, 0, 0); PG8_STAGE(PG8_SA(1, 1), a1 + hstepA, voffA);
            PG8_WAIT_L(8); PG8_BAR; PG8_WAIT_L(0); PG8_MMA(0, 0, At, B0); PG8_BAR; PG8_SCHED;
            PG8_LDB(B1, 0, 1); PG8_STAGE(PG8_SB(0, 0), b2, voffB);
            PG8_BAR; PG8_WAIT_L(0); PG8_MMA(0, 1, At, B1); PG8_BAR;
            PG8_LDA(At, 0, 1); PG8_STAGE(PG8_SA(0, 0), a2, voffA);
            PG8_BAR; PG8_WAIT_L(0); PG8_MMA(1, 0, At, B0); PG8_BAR; PG8_SCHED;
            PG8_STAGE(PG8_SB(0, 1), b2 + hstepB, voffB);
            PG8_WAIT_V(6); PG8_BAR; PG8_MMA(1, 1, At, B1); PG8_BAR;
            PG8_LDB(B0, 1, 0); PG8_SCHED; PG8_LDA(At, 1, 0); PG8_STAGE(PG8_SA(0, 1), a2 + hstepA, voffA);
            PG8_WAIT_L(8); PG8_BAR; PG8_WAIT_L(0); PG8_MMA(0, 0, At, B0); PG8_BAR; PG8_SCHED;
            PG8_LDB(B1, 1, 1); PG8_STAGE(PG8_SB(1, 0), b3, voffB);
            PG8_BAR; PG8_WAIT_L(0); PG8_MMA(0, 1, At, B1); PG8_BAR;
            PG8_LDA(At, 1, 1); PG8_STAGE(PG8_SA(1, 0), a3, voffA);
            PG8_BAR; PG8_WAIT_L(0); PG8_MMA(1, 0, At, B0); PG8_BAR; PG8_SCHED;
            PG8_STAGE(PG8_SB(1, 1), b3 + hstepB, voffB);
            PG8_WAIT_V(6); PG8_BAR; PG8_MMA(1, 1, At, B1); PG8_BAR;
            }
        }
        if constexpr (ALIGN_EPI) { if (wr == 0) PG8_BAR; }
        E(acc, cur, wr, wc, fr, fq);
        if (!has_next) break;
#pragma unroll
        for (int a = 0; a < 2; ++a)
#pragma unroll
            for (int b = 0; b < 2; ++b)
#pragma unroll
                for (int m = 0; m < 4; ++m)
#pragma unroll
                    for (int n = 0; n < 2; ++n) acc[a][b][m][n] = (f32x4){0.f, 0.f, 0.f, 0.f};
        cur = nxt; cA = nA; cB = nB; ++ui;
        if constexpr (ALIGN_EPI) { if (wr == 1) PG8_BAR; }
    }
    PG8_WAIT_V(0);
    if constexpr (!ALIGN_EPI) { if (wr == 0) PG8_BAR; }
    PG8_BAR;
#undef PG8_SA
#undef PG8_SB
#undef PG8_STAGE
#undef PG8_LDA
#undef PG8_LDB
#undef PG8_MMA
#undef PG8_WAIT_V
#undef PG8_WAIT_L
#undef PG8_BAR
#undef PG8_SCHED
}

template <int MODE> struct EpiBf {
    static constexpr bool PERM = true; static constexpr int MID_T = 0;
    bf16_t* O; int ldc; const bf16_t* gate; int ldg; const bf16_t* addend;
    __device__ __forceinline__ void operator()(const f32x4 (&acc)[2][2][4][2], const Unit& u, int wr, int wc, int fr, int fq) const {
        const int row0 = u.pm * BM + wr * 64 + fr, col0 = u.pn * BM + wc * 32 + 8 * fq;
#pragma unroll
        for (int ai = 0; ai < 2; ++ai)
#pragma unroll
            for (int m = 0; m < 4; ++m) { const size_t row = (size_t)(row0 + ai * HALF + m * 16);
#pragma unroll
                for (int bj = 0; bj < 2; ++bj) { f32x4 v0 = acc[ai][bj][m][0], v1 = acc[ai][bj][m][1]; const int col = col0 + bj * HALF;
                    if (MODE >= 1) { const u32x4 gv = *(const u32x4*)(gate + row * ldg + col);
                        v0[0] *= sigmoidf_(bflo(gv.x)); v0[1] *= sigmoidf_(bfhi(gv.x)); v0[2] *= sigmoidf_(bflo(gv.y)); v0[3] *= sigmoidf_(bfhi(gv.y));
                        v1[0] *= sigmoidf_(bflo(gv.z)); v1[1] *= sigmoidf_(bfhi(gv.z)); v1[2] *= sigmoidf_(bflo(gv.w)); v1[3] *= sigmoidf_(bfhi(gv.w)); }
                    if (MODE == 2) { const u32x4 av = *(const u32x4*)(addend + row * ldc + col);
                        v0[0] += bflo(av.x); v0[1] += bfhi(av.x); v0[2] += bflo(av.y); v0[3] += bfhi(av.y);
                        v1[0] += bflo(av.z); v1[1] += bfhi(av.z); v1[2] += bflo(av.w); v1[3] += bfhi(av.w); }
                    u32x4 w; w.x = pk2(v0[0], v0[1]); w.y = pk2(v0[2], v0[3]); w.z = pk2(v1[0], v1[1]); w.w = pk2(v1[2], v1[3]);
                    *(u32x4*)(O + row * ldc + col) = w; } }
    }
};
#define EPI_FENCE() asm volatile("" ::: "memory")
struct EpiMerge {
    static constexpr bool PERM = true; static constexpr int MID_T = AOUT / BK;
    bf16_t* O; const bf16_t* ga; const bf16_t* gr; int ldg;
    __device__ __forceinline__ void mid(f32x4 (&acc)[2][2][4][2], const Unit& u, int wr, int wc, int fr, int fq) const {
        int row0 = u.pm * BM + wr * 64 + fr, col0 = u.pn * BM + wc * 32 + 8 * fq;
        asm volatile("" : "+v"(row0), "+v"(col0));
#pragma unroll
        for (int ah = 0; ah < 4; ++ah) {
            const int ai = ah >> 1, mh = ah & 1;
            u32x4 a[2][2], r[2][2];
#pragma unroll
            for (int mm = 0; mm < 2; ++mm)
#pragma unroll
                for (int bj = 0; bj < 2; ++bj) { const size_t o = (size_t)(row0 + ai * HALF + (2 * mh + mm) * 16) * ldg + col0 + bj * HALF; a[mm][bj] = *(const u32x4*)(ga + o); r[mm][bj] = *(const u32x4*)(gr + o); }
            EPI_FENCE();
#pragma unroll
            for (int mm = 0; mm < 2; ++mm)
#pragma unroll
                for (int bj = 0; bj < 2; ++bj) { const int m = 2 * mh + mm; const u32x4 av = a[mm][bj], rv = r[mm][bj];
                    f32x4& v0 = acc[ai][bj][m][0]; f32x4& v1 = acc[ai][bj][m][1];
                    v0[0] *= sigmoidf_(bflo(av.x)) * (1.0f + __expf(-bflo(rv.x))); v0[1] *= sigmoidf_(bfhi(av.x)) * (1.0f + __expf(-bfhi(rv.x)));
                    v0[2] *= sigmoidf_(bflo(av.y)) * (1.0f + __expf(-bflo(rv.y))); v0[3] *= sigmoidf_(bfhi(av.y)) * (1.0f + __expf(-bfhi(rv.y)));
                    v1[0] *= sigmoidf_(bflo(av.z)) * (1.0f + __expf(-bflo(rv.z))); v1[1] *= sigmoidf_(bfhi(av.z)) * (1.0f + __expf(-bfhi(rv.z)));
                    v1[2] *= sigmoidf_(bflo(av.w)) * (1.0f + __expf(-bflo(rv.w))); v1[3] *= sigmoidf_(bfhi(av.w)) * (1.0f + __expf(-bfhi(rv.w))); }
            EPI_FENCE();
        }
    }
    __device__ __forceinline__ void operator()(const f32x4 (&acc)[2][2][4][2], const Unit& u, int wr, int wc, int fr, int fq) const {
        const int row0 = u.pm * BM + wr * 64 + fr, col0 = u.pn * BM + wc * 32 + 8 * fq;
#pragma unroll
        for (int ah = 0; ah < 4; ++ah) {
            const int ai = ah >> 1, mh = ah & 1;
            u32x4 r[2][2];
#pragma unroll
            for (int mm = 0; mm < 2; ++mm)
#pragma unroll
                for (int bj = 0; bj < 2; ++bj) r[mm][bj] = *(const u32x4*)(gr + (size_t)(row0 + ai * HALF + (2 * mh + mm) * 16) * ldg + col0 + bj * HALF);
            EPI_FENCE();
#pragma unroll
            for (int mm = 0; mm < 2; ++mm)
#pragma unroll
                for (int bj = 0; bj < 2; ++bj) { const int m = 2 * mh + mm; const u32x4 rv = r[mm][bj]; const f32x4 v0 = acc[ai][bj][m][0], v1 = acc[ai][bj][m][1];
                    u32x4 w; w.x = pk2(v0[0] * sigmoidf_(bflo(rv.x)), v0[1] * sigmoidf_(bfhi(rv.x))); w.y = pk2(v0[2] * sigmoidf_(bflo(rv.y)), v0[3] * sigmoidf_(bfhi(rv.y)));
                    w.z = pk2(v1[0] * sigmoidf_(bflo(rv.z)), v1[1] * sigmoidf_(bfhi(rv.z))); w.w = pk2(v1[2] * sigmoidf_(bflo(rv.w)), v1[3] * sigmoidf_(bfhi(rv.w)));
                    *(u32x4*)(O + (size_t)(row0 + ai * HALF + m * 16) * D + col0 + bj * HALF) = w; }
            EPI_FENCE();
        }
    }
};
struct EpiResid {
    static constexpr bool PERM = true; static constexpr int MID_T = 0;
    bf16_t* out; const float* base; const float* gvec;
    __device__ __forceinline__ void operator()(const f32x4 (&acc)[2][2][4][2], const Unit& u, int wr, int wc, int fr, int fq) const {
        const int row0 = u.pm * BM + wr * 64 + fr, col0 = u.pn * BM + wc * 32 + 8 * fq;
        const float* gv = gvec + (size_t)(row0 >> 11) * MOD6 + col0;
        f32x4 g4[2][2];
#pragma unroll
        for (int bj = 0; bj < 2; ++bj)
#pragma unroll
            for (int n = 0; n < 2; ++n) g4[bj][n] = *(const f32x4*)(gv + bj * HALF + 4 * n);
#pragma unroll
        for (int ai = 0; ai < 2; ++ai)
#pragma unroll
            for (int mh = 0; mh < 2; ++mh) {
                f32x4 b[2][2][2];
#pragma unroll
                for (int mm = 0; mm < 2; ++mm)
#pragma unroll
                    for (int bj = 0; bj < 2; ++bj) { const size_t off = (size_t)(row0 + ai * HALF + (2 * mh + mm) * 16) * D + col0 + bj * HALF; b[mm][bj][0] = *(const f32x4*)(base + off); b[mm][bj][1] = *(const f32x4*)(base + off + 4); }
                EPI_FENCE();
#pragma unroll
                for (int mm = 0; mm < 2; ++mm)
#pragma unroll
                    for (int bj = 0; bj < 2; ++bj) { const int m = 2 * mh + mm; const size_t off = (size_t)(row0 + ai * HALF + m * 16) * D + col0 + bj * HALF;
                        const f32x4 v0 = b[mm][bj][0] * ALPHA + g4[bj][0] * acc[ai][bj][m][0], v1 = b[mm][bj][1] * ALPHA + g4[bj][1] * acc[ai][bj][m][1];
                        u32x4 w; w.x = pk2(v0[0], v0[1]); w.y = pk2(v0[2], v0[3]); w.z = pk2(v1[0], v1[1]); w.w = pk2(v1[2], v1[3]);
                        *(u32x4*)(out + off) = w; }
                EPI_FENCE();
            }
    }
};
struct EpiResidLn {
    static constexpr bool PERM = true; static constexpr int MID_T = 0;
    bf16_t* out; const bf16_t* r1; const float* stats; const float* gam; const float* bet; const float* gvec;
    __device__ __forceinline__ void operator()(const f32x4 (&acc)[2][2][4][2], const Unit& u, int wr, int wc, int fr, int fq) const {
        const int row0 = u.pm * BM + wr * 64 + fr, col0 = u.pn * BM + wc * 32 + 8 * fq;
        const float* gv = gvec + (size_t)(row0 >> 11) * MOD6 + col0;
#pragma unroll
        for (int bj = 0; bj < 2; ++bj) {
            f32x4 g4[2], ga[2], be[2];
#pragma unroll
            for (int n = 0; n < 2; ++n) { g4[n] = *(const f32x4*)(gv + bj * HALF + 4 * n); ga[n] = *(const f32x4*)(gam + col0 + bj * HALF + 4 * n) * ALPHA; be[n] = *(const f32x4*)(bet + col0 + bj * HALF + 4 * n) * ALPHA; }
#pragma unroll
            for (int ai = 0; ai < 2; ++ai) {
                u32x4 t[4]; float mean[4], rstd[4];
#pragma unroll
                for (int m = 0; m < 4; ++m) { const int row = row0 + ai * HALF + m * 16; mean[m] = stats[2 * row]; rstd[m] = stats[2 * row + 1]; t[m] = *(const u32x4*)(r1 + (size_t)row * D + col0 + bj * HALF); }
                EPI_FENCE();
#pragma unroll
                for (int m = 0; m < 4; ++m) { const u32x4 tv = t[m];
                    const f32x4 x0 = ((f32x4){bflo(tv.x), bfhi(tv.x), bflo(tv.y), bfhi(tv.y)} - mean[m]) * rstd[m], x1 = ((f32x4){bflo(tv.z), bfhi(tv.z), bflo(tv.w), bfhi(tv.w)} - mean[m]) * rstd[m];
                    const f32x4 v0 = x0 * ga[0] + be[0] + g4[0] * acc[ai][bj][m][0], v1 = x1 * ga[1] + be[1] + g4[1] * acc[ai][bj][m][1];
                    u32x4 w; w.x = pk2(v0[0], v0[1]); w.y = pk2(v0[2], v0[3]); w.z = pk2(v1[0], v1[1]); w.w = pk2(v1[2], v1[3]);
                    *(u32x4*)(out + (size_t)(row0 + ai * HALF + m * 16) * D + col0 + bj * HALF) = w; }
                EPI_FENCE();
            }
        }
    }
};
}

struct Params { const float* in[24]; float* out; unsigned char* ws; };
enum { I_X = 0, I_C, I_WADA, I_BADA, I_WIN, I_RELB, I_LCW, I_LCB, I_LWA, I_LBA, I_LWX, I_LBX, I_LLAM, I_WPA, I_WPL, I_WOUT, I_LN1G, I_LN1B, I_WUP, I_FCW, I_FCB, I_WDN, I_LN2G, I_LN2B };

__device__ __forceinline__ void p0_transpose_item(const float* W, int K, int N, bf16_t* WT, float* scr, int item, int lane, int ldw = 0) {
    if (ldw == 0) ldw = K;
    const int nblk = N / 32, kb = item / nblk, nb = item % nblk, k0 = 64 * kb, n0 = 32 * nb;
#pragma unroll 8
    for (int i = 0; i < 32; ++i) { const int kk = 2 * i + (lane >> 5); scr[kk * 33 + (lane & 31)] = W[(size_t)(k0 + kk) * N + n0 + (lane & 31)]; }
    asm volatile("s_waitcnt lgkmcnt(0)" ::: "memory");
    const int c = lane & 7;
#pragma unroll
    for (int j = 0; j < 4; ++j) { const int n = (lane >> 3) + 8 * j; const float* s = scr + (8 * c) * 33 + n;
        u32x4 o; o.x = pk2(s[0 * 33], s[1 * 33]); o.y = pk2(s[2 * 33], s[3 * 33]); o.z = pk2(s[4 * 33], s[5 * 33]); o.w = pk2(s[6 * 33], s[7 * 33]);
        *(u32x4*)(WT + (size_t)(n0 + n) * ldw + k0 + 8 * c) = o; }
    asm volatile("s_waitcnt lgkmcnt(0)" ::: "memory");
}

__device__ __forceinline__ void phase0(const Params& p, unsigned char* smem, int bid, int G) {
    const int tid = opaque_tid(), lane = tid & 63, wave = tid >> 6;
    unsigned char* ws = p.ws;
    for (int j = bid; j < 192; j += G) {
        float* sc = (float*)smem;
        for (int i = tid; i < NB * D; i += 512) { const int b = i & 31, k = i >> 5; const float v = p.in[I_C][b * D + k]; sc[k * 32 + b] = v / (1.0f + __expf(-v)); }
        __syncthreads();
        const int cl = lane & 31, bh = lane >> 5;
        const float* wp = p.in[I_WADA] + 32 * j + cl;
        f32x4 a0 = (f32x4){0.f, 0.f, 0.f, 0.f}, a1 = a0, a2 = a0, a3 = a0;
#pragma unroll 8
        for (int kk = 0; kk < 128; ++kk) { const int k = 128 * wave + kk; const float wv = wp[(size_t)k * MOD6]; const f32x4* sp = (const f32x4*)(sc + k * 32 + 16 * bh);
            a0 += sp[0] * wv; a1 += sp[1] * wv; a2 += sp[2] * wv; a3 += sp[3] * wv; }
        __syncthreads();
        float* red = (float*)smem;
        { float* rp = red + wave * 1024 + (16 * bh) * 32 + cl;
#pragma unroll
          for (int i = 0; i < 4; ++i) { rp[(i) * 32] = a0[i]; rp[(4 + i) * 32] = a1[i]; rp[(8 + i) * 32] = a2[i]; rp[(12 + i) * 32] = a3[i]; } }
        __syncthreads();
        float* mod = (float*)(ws + WS_MOD);
        for (int o = tid; o < 1024; o += 512) { float sum = 0.f;
#pragma unroll
            for (int w8 = 0; w8 < 8; ++w8) sum += red[w8 * 1024 + o];
            const int b = o >> 5, col = 32 * j + (o & 31); mod[(size_t)b * MOD6 + col] = sum + p.in[I_BADA][col]; }
        __syncthreads();
    }
    float* scr = (float*)(smem + wave * 16384);
    const int gw = bid * 8 + wave, NGW = G * 8;
    constexpr int I_1 = (D / 64) * (INC / 32), I_2 = (AOUT / 64) * (D / 32), I_3 = (D / 64) * (D / 32), I_4 = I_3, I_5 = (D / 64) * (FF2 / 32), I_6 = (FF / 64) * (D / 32), I_7 = 16 * 2;
    constexpr int NIT = I_1 + I_2 + I_3 + I_4 + I_5 + I_6 + 2 * I_7;
    for (int it = gw; it < NIT; it += NGW) {
        int r = it;
        if (r < I_1) { p0_transpose_item(p.in[I_WIN], D, INC, (bf16_t*)(ws + WS_WIN), scr, r, lane); continue; } r -= I_1;
        if (r < I_2) { p0_transpose_item(p.in[I_WPA], AOUT, D, (bf16_t*)(ws + WS_WPA), scr, r, lane, K2); continue; } r -= I_2;
        if (r < I_3) { p0_transpose_item(p.in[I_WPL], D, D, (bf16_t*)(ws + WS_WPA) + AOUT, scr, r, lane, K2); continue; } r -= I_3;
        if (r < I_4) { p0_transpose_item(p.in[I_WOUT], D, D, (bf16_t*)(ws + WS_WOUT), scr, r, lane); continue; } r -= I_4;
        if (r < I_5) { p0_transpose_item(p.in[I_WUP], D, FF2, (bf16_t*)(ws + WS_WUP), scr, r, lane); continue; } r -= I_5;
        if (r < I_6) { p0_transpose_item(p.in[I_WDN], FF, D, (bf16_t*)(ws + WS_WDN), scr, r, lane); continue; } r -= I_6;
        if (r < I_7) { const int blk = r >> 1; p0_transpose_item(p.in[I_LWA] + blk * 4096, 64, 64, (bf16_t*)(ws + WS_WLRU) + blk * 4096, scr, r & 1, lane); continue; } r -= I_7;
        { const int blk = r >> 1; p0_transpose_item(p.in[I_LWX] + blk * 4096, 64, 64, (bf16_t*)(ws + WS_WLRU) + 65536 + blk * 4096, scr, r & 1, lane); }
    }
}

__device__ __forceinline__ void phase_modx(const Params& p, int chunk, int bid, int G) {
    const float* x = p.in[I_X] + (size_t)chunk * MC * D;
    const float* mod = (const float*)(p.ws + WS_MOD) + (size_t)chunk * CB * MOD6;
    bf16_t* U = (bf16_t*)(p.ws + WS_U);
    const int tid = opaque_tid(), c8 = (tid & 127) * 8, rl = tid >> 7;
    for (int tile = bid; tile < MC / 64; tile += G) {
        const int r0 = tile * 64, b = r0 >> 11;
        const float* mp = mod + (size_t)b * MOD6 + c8;
        const f32x4 sh0 = *(const f32x4*)(mp), sh1 = *(const f32x4*)(mp + 4), sc0 = *(const f32x4*)(mp + D) + 1.0f, sc1 = *(const f32x4*)(mp + D + 4) + 1.0f;
#pragma unroll 8
        for (int i = 0; i < 16; ++i) { const size_t off = (size_t)(r0 + rl + 4 * i) * D + c8;
            const f32x4 x0 = *(const f32x4*)(x + off), x1 = *(const f32x4*)(x + off + 4);
            const f32x4 u0 = x0 * sc0 + sh0, u1 = x1 * sc1 + sh1;
            u32x4 w; w.x = pk2(u0[0], u0[1]); w.y = pk2(u0[2], u0[3]); w.z = pk2(u1[0], u1[1]); w.w = pk2(u1[2], u1[3]);
            *(u32x4*)(U + off) = w; }
    }
}

__device__ __forceinline__ void phase_merge(const Params& p, int bid, int G) {
    const bf16_t* og = (const bf16_t*)(p.ws + WS_OG); const float* lse = (const float*)(p.ws + WS_LSE); bf16_t* oa = (bf16_t*)(p.ws + WS_OATT);
    const int nthr = G * 512;
#pragma unroll 2
    for (int i = bid * 512 + opaque_tid(); i < MC * AOUT / 8; i += nthr) {
        const int row = i >> 6, c8 = (i & 63) * 8, h = c8 >> 6;
        const float l0 = lse[(size_t)row * 8 + h], l1 = lse[(size_t)(MC + row) * 8 + h], l2 = lse[(size_t)(2 * MC + row) * 8 + h];
        const float mx = fmaxf(l0, fmaxf(l1, l2));
        float w0 = __expf(l0 - mx), w1 = __expf(l1 - mx), w2 = __expf(l2 - mx);
        const float inv = 1.0f / (w0 + w1 + w2); w0 *= inv; w1 *= inv; w2 *= inv;
        const u32x4 a = *(const u32x4*)(og + (size_t)row * AOUT + c8), b = *(const u32x4*)(og + (size_t)(MC + row) * AOUT + c8), c = *(const u32x4*)(og + (size_t)(2 * MC + row) * AOUT + c8);
        u32x4 o;
        o.x = pk2(w0 * bflo(a.x) + w1 * bflo(b.x) + w2 * bflo(c.x), w0 * bfhi(a.x) + w1 * bfhi(b.x) + w2 * bfhi(c.x));
        o.y = pk2(w0 * bflo(a.y) + w1 * bflo(b.y) + w2 * bflo(c.y), w0 * bfhi(a.y) + w1 * bfhi(b.y) + w2 * bfhi(c.y));
        o.z = pk2(w0 * bflo(a.z) + w1 * bflo(b.z) + w2 * bflo(c.z), w0 * bfhi(a.z) + w1 * bfhi(b.z) + w2 * bfhi(c.z));
        o.w = pk2(w0 * bflo(a.w) + w1 * bflo(b.w) + w2 * bflo(c.w), w0 * bfhi(a.w) + w1 * bfhi(b.w) + w2 * bfhi(c.w));
        *(u32x4*)(oa + (size_t)row * K2 + c8) = o;
    }
}

template <bool SECOND>
__device__ __forceinline__ void phase_ln(const Params& p, int chunk, int bid, int G) {
    const int tid_ = opaque_tid(); const int lane = tid_ & 63, wave = tid_ >> 6;
    float* R = p.out + (size_t)chunk * MC * D;
    const bf16_t* Rb = (const bf16_t*)(p.ws + (SECOND ? WS_OATT : WS_YAG));
    float* stats = (float*)(p.ws + WS_LSE);
    const float* gam = p.in[SECOND ? I_LN2G : I_LN1G]; const float* bet = p.in[SECOND ? I_LN2B : I_LN1B];
    const float* mod = (const float*)(p.ws + WS_MOD) + (size_t)chunk * CB * MOD6;
    bf16_t* U = (bf16_t*)(p.ws + WS_U);
    f32x4 gg[4], bb[4];
#pragma unroll
    for (int j = 0; j < 4; ++j) { gg[j] = *(const f32x4*)(gam + 4 * lane + 256 * j); bb[j] = *(const f32x4*)(bet + 4 * lane + 256 * j); }
    for (int rg = bid * 8 + wave; rg < MC / 16; rg += G * 8) {
        const int rbase = rg * 16, b = rbase >> 11;
        f32x4 sh[4], sc[4];
        if (!SECOND) {
#pragma unroll
            for (int j = 0; j < 4; ++j) { const float* mp = mod + (size_t)b * MOD6 + 4 * lane + 256 * j; sh[j] = *(const f32x4*)(mp + 3 * D); sc[j] = *(const f32x4*)(mp + 4 * D) + 1.0f; } }
#pragma unroll 1
        for (int rr = 0; rr < 16; rr += 2) {
            const int row0 = rbase + rr;
            f32x4 v[2][4]; float s[2] = {0.f, 0.f};
#pragma unroll
            for (int q = 0; q < 2; ++q) { const u32x2* xr = (const u32x2*)(Rb + (size_t)(row0 + q) * D) + lane;
#pragma unroll
                for (int j = 0; j < 4; ++j) { const u32x2 t = xr[64 * j]; v[q][j] = (f32x4){bflo(t.x), bfhi(t.x), bflo(t.y), bfhi(t.y)}; } }
#pragma unroll
            for (int q = 0; q < 2; ++q)
#pragma unroll
                for (int j = 0; j < 4; ++j) s[q] += (v[q][j].x + v[q][j].y) + (v[q][j].z + v[q][j].w);
            const float mean0 = wave_sum(s[0]) * (1.f / D), mean1 = wave_sum(s[1]) * (1.f / D);
            float s2[2] = {0.f, 0.f};
#pragma unroll
            for (int q = 0; q < 2; ++q) { const float mean = q ? mean1 : mean0;
#pragma unroll
                for (int j = 0; j < 4; ++j) { v[q][j] = v[q][j] - mean; s2[q] += (v[q][j].x * v[q][j].x + v[q][j].y * v[q][j].y) + (v[q][j].z * v[q][j].z + v[q][j].w * v[q][j].w); } }
            const float rstd0 = rsqrtf(wave_sum(s2[0]) * (1.f / D) + LN_EPS), rstd1 = rsqrtf(wave_sum(s2[1]) * (1.f / D) + LN_EPS);
            if (!SECOND && lane < 2) { stats[2 * (row0 + lane)] = lane ? mean1 : mean0; stats[2 * (row0 + lane) + 1] = lane ? rstd1 : rstd0; }
#pragma unroll
            for (int j = 0; j < 4; ++j) { const int c = 4 * lane + 256 * j;
#pragma unroll
                for (int q = 0; q < 2; ++q) { const f32x4 y = v[q][j] * (q ? rstd1 : rstd0) * gg[j] + bb[j];
                    if (SECOND) *(f32x4*)(R + (size_t)(row0 + q) * D + c) = y;
                    if (!SECOND) { const f32x4 u = y * sc[j] + sh[j]; u32x2 w; w.x = pk2(u[0], u[1]); w.y = pk2(u[2], u[3]); *(u32x2*)(U + (size_t)(row0 + q) * D + c) = w; } }
            }
        }
    }
}

__device__ __forceinline__ void phase_convgate(const Params& p, int bid, int G) {
    const bf16_t* up = (const bf16_t*)(p.ws + WS_UP); bf16_t* act = (bf16_t*)(p.ws + WS_ACT);
    const float* cw = p.in[I_FCW]; const float* cb = p.in[I_FCB];
    constexpr int RB = 32, NCG = FF / 8;
    const int nthr = G * 512;
    for (int item = bid * 512 + opaque_tid(); item < (MC / RB) * NCG; item += nthr) {
        const int cg = item % NCG, rb = item / NCG, c8 = cg * 8, row0 = rb * RB, t0 = row0 & (SEQ - 1);
        f32x4 wv[3][2], wg[3][2], bv[2], bg[2];
#pragma unroll
        for (int k = 0; k < 3; ++k) { wv[k][0] = *(const f32x4*)(cw + k * FF2 + c8); wv[k][1] = *(const f32x4*)(cw + k * FF2 + c8 + 4);
            wg[k][0] = *(const f32x4*)(cw + k * FF2 + FF + c8); wg[k][1] = *(const f32x4*)(cw + k * FF2 + FF + c8 + 4); }
        bv[0] = *(const f32x4*)(cb + c8); bv[1] = *(const f32x4*)(cb + c8 + 4); bg[0] = *(const f32x4*)(cb + FF + c8); bg[1] = *(const f32x4*)(cb + FF + c8 + 4);
        const bf16_t* rp = up + (size_t)row0 * FF2 + c8;
        u32x4 a2 = (u32x4){0u, 0u, 0u, 0u}, b2 = a2, a1 = a2, b1 = a2;
        if (t0 > 0) { a2 = *(const u32x4*)(rp - 2 * FF2); b2 = *(const u32x4*)(rp - 2 * FF2 + FF); a1 = *(const u32x4*)(rp - FF2); b1 = *(const u32x4*)(rp - FF2 + FF); }
#pragma unroll 4
        for (int i = 0; i < RB; ++i) {
            const u32x4 a0 = *(const u32x4*)(rp + (size_t)i * FF2), b0 = *(const u32x4*)(rp + (size_t)i * FF2 + FF);
            f32x4 v0 = bv[0], v1 = bv[1], g0 = bg[0], g1 = bg[1];
#define CG_ACC(A, B, K) do { \
            v0 += wv[K][0] * (f32x4){bflo(A.x), bfhi(A.x), bflo(A.y), bfhi(A.y)}; v1 += wv[K][1] * (f32x4){bflo(A.z), bfhi(A.z), bflo(A.w), bfhi(A.w)}; \
            g0 += wg[K][0] * (f32x4){bflo(B.x), bfhi(B.x), bflo(B.y), bfhi(B.y)}; g1 += wg[K][1] * (f32x4){bflo(B.z), bfhi(B.z), bflo(B.w), bfhi(B.w)}; } while (0)
            CG_ACC(a2, b2, 0); CG_ACC(a1, b1, 1); CG_ACC(a0, b0, 2);
#undef CG_ACC
            u32x4 o;
            o.x = pk2(gelu_tanh(g0[0]) * v0[0], gelu_tanh(g0[1]) * v0[1]); o.y = pk2(gelu_tanh(g0[2]) * v0[2], gelu_tanh(g0[3]) * v0[3]);
            o.z = pk2(gelu_tanh(g1[0]) * v1[0], gelu_tanh(g1[1]) * v1[1]); o.w = pk2(gelu_tanh(g1[2]) * v1[2], gelu_tanh(g1[3]) * v1[3]);
            *(u32x4*)(act + (size_t)(row0 + i) * FF + c8) = o;
            a2 = a1; b2 = b1; a1 = a0; b1 = b0;
        }
    }
}

typedef short v4i16_t __attribute__((ext_vector_type(4)));
__device__ __forceinline__ s16x4 vtr(const unsigned char* pp) { return __builtin_bit_cast(s16x4, __builtin_amdgcn_ds_read_tr16_b64_v4i16((LAS v4i16_t*)(LAS unsigned char*)pp)); }

struct AttnRegs { u32x4 k[4], v[4]; bf16x8 q0, q1; };
__device__ __forceinline__ void attn_decode(int item, int& b, int& g, int& h, int& d, int& r, int& n) {
    const int sub = item & 15, bgh = item >> 4, bg = bgh >> 3; h = bgh & 7; g = bg % 3; b = bg / 3;
    if (g == 0) { d = 1; r = 0; n = sub; } else if (g == 1) { d = 4; r = sub >> 2; n = sub & 3; } else { d = 16; r = sub; n = 0; }
}
__device__ __forceinline__ void attn_load(const Params& p, int item, AttnRegs& R, int tid) {
    int b, g, h, d, r, n; attn_decode(item, b, g, h, d, r, n);
    const int lane = tid & 63, w = tid >> 6, fr = lane & 15, fq = lane >> 4, hc = (g * 8 + h) * 64;
    const bf16_t* pb = (const bf16_t*)(p.ws + WS_PROJ) + (size_t)b * SEQ * INC;
#pragma unroll
    for (int c = 0; c < 4; ++c) { const int i = tid + 512 * c, j = i >> 3, ch = i & 7;
        R.k[c] = (u32x4){0u, 0u, 0u, 0u}; R.v[c] = (u32x4){0u, 0u, 0u, 0u};
        if (n > 0 || j >= 128) { const int tok = ((n - 1) * 128 + j) * d + r; const bf16_t* q = pb + (size_t)tok * INC + hc + ch * 8; R.k[c] = *(const u32x4*)(q + OFF_K); R.v[c] = *(const u32x4*)(q + OFF_V); } }
    const int qtok = (n * 128 + 16 * w + fr) * d + r;
    const bf16_t* qp = pb + (size_t)qtok * INC + hc + fq * 8;
    R.q0 = *(const bf16x8*)qp; R.q1 = *(const bf16x8*)(qp + 32);
}
__device__ __forceinline__ void attn_compute(const Params& p, unsigned char* smem, int item, AttnRegs& R, int nxt, const float (&bias)[9][4]) {
    const int tid = opaque_tid(), lane = tid & 63, w = tid >> 6, fr = lane & 15, fq = lane >> 4;
    int b, g, h, d, r, n; attn_decode(item, b, g, h, d, r, n);
    unsigned char* Ks = smem; unsigned char* Vs = smem + 36864; float* tb = (float*)(smem + 73728);
#pragma unroll
    for (int c = 0; c < 4; ++c) { const int i = tid + 512 * c, j = i >> 3, ch = i & 7;
        *(u32x4*)(Ks + j * 144 + ch * 16) = R.k[c]; *(u32x4*)(Vs + j * 144 + ch * 16) = R.v[c]; }
    const bf16x8 qf0 = R.q0, qf1 = R.q1;
    const int qtok = (n * 128 + 16 * w + fr) * d + r;
    __syncthreads();
    if (nxt >= 0) attn_load(p, nxt, R, tid);
    f32x4 s[9];
    const int wu = __builtin_amdgcn_readfirstlane(w);
#pragma unroll
    for (int t = 0; t < 9; ++t) {
        const unsigned char* kp = Ks + (16 * (wu + t) + fr) * 144 + fq * 16;
        const bf16x8 k0 = *(const bf16x8*)kp, k1 = *(const bf16x8*)(kp + 64);
        f32x4 z = (f32x4){0.f, 0.f, 0.f, 0.f};
        z = __builtin_amdgcn_mfma_f32_16x16x32_bf16(k0, qf0, z, 0, 0, 0);
        z = __builtin_amdgcn_mfma_f32_16x16x32_bf16(k1, qf1, z, 0, 0, 0);
        const bool live = (n > 0) || (wu + t >= 8);
        f32x4 a;
#pragma unroll
        for (int e = 0; e < 4; ++e) a[e] = z[e] * 0.125f + (live ? bias[t][e] : -1e30f);
        s[t] = a; }
    s16x4 vlo[5][4], vhi[5][4];
#pragma unroll
    for (int pp = 0; pp < 5; ++pp) { const int tA = 2 * pp, tB = (2 * pp + 1 < 9) ? 2 * pp + 1 : 2 * pp;
        const unsigned char* va = Vs + (16 * (wu + tA) + 4 * fq + (fr >> 2)) * 144 + 8 * (fr & 3);
        const unsigned char* vb = Vs + (16 * (wu + tB) + 4 * fq + (fr >> 2)) * 144 + 8 * (fr & 3);
#pragma unroll
        for (int mt = 0; mt < 4; ++mt) { vlo[pp][mt] = vtr(va + 32 * mt); vhi[pp][mt] = vtr(vb + 32 * mt); } }
    float mx = -1e30f;
#pragma unroll
    for (int t = 0; t < 9; ++t)
#pragma unroll
        for (int e = 0; e < 4; ++e) mx = fmaxf(mx, s[t][e]);
    mx = fmaxf(mx, __shfl_xor(mx, 16)); mx = fmaxf(mx, __shfl_xor(mx, 32));
    float sum = 0.f;
#pragma unroll
    for (int t = 0; t < 9; ++t)
#pragma unroll
        for (int e = 0; e < 4; ++e) { const float pv = __expf(s[t][e] - mx); s[t][e] = pv; sum += pv; }
    sum += __shfl_xor(sum, 16); sum += __shfl_xor(sum, 32);
    f32x4 o[4];
#pragma unroll
    for (int mt = 0; mt < 4; ++mt) o[mt] = (f32x4){0.f, 0.f, 0.f, 0.f};
#pragma unroll
    for (int pp = 0; pp < 5; ++pp) { const int tA = 2 * pp, tB = (2 * pp + 1 < 9) ? 2 * pp + 1 : 2 * pp;
        u32x4 pw; pw.x = pk2(s[tA][0], s[tA][1]); pw.y = pk2(s[tA][2], s[tA][3]);
        if (2 * pp + 1 < 9) { pw.z = pk2(s[tB][0], s[tB][1]); pw.w = pk2(s[tB][2], s[tB][3]); } else { pw.z = 0u; pw.w = 0u; }
        const bf16x8 pf = __builtin_bit_cast(bf16x8, pw);
#pragma unroll
        for (int mt = 0; mt < 4; ++mt) { const s16x4 lo = vlo[pp][mt], hi = vhi[pp][mt];
            bf16x8 vf; vf[0] = lo[0]; vf[1] = lo[1]; vf[2] = lo[2]; vf[3] = lo[3]; vf[4] = hi[0]; vf[5] = hi[1]; vf[6] = hi[2]; vf[7] = hi[3];
            o[mt] = __builtin_amdgcn_mfma_f32_16x16x32_bf16(vf, pf, o[mt], 0, 0, 0); } }
    const float inv = __builtin_amdgcn_rcpf(sum);
    const size_t orow = (size_t)g * MC + (size_t)b * SEQ + qtok;
    bf16_t* op = (bf16_t*)(p.ws + WS_OG) + orow * AOUT + h * 64 + 4 * fq;
#pragma unroll
    for (int mt = 0; mt < 4; ++mt) { u32x2 wv; wv.x = pk2(o[mt][0] * inv, o[mt][1] * inv); wv.y = pk2(o[mt][2] * inv, o[mt][3] * inv); *(u32x2*)(op + 16 * mt) = wv; }
    if (fq == 0) ((float*)(p.ws + WS_LSE))[orow * 8 + h] = mx + __logf(sum);
}

__device__ __forceinline__ void lru_item(const Params& p, unsigned char* smem, int item) {
    const int tid = opaque_tid(), lane = tid & 63, w = tid >> 6, fr = lane & 15, fq = lane >> 4;
    const int b = item >> 4, nb = item & 15, ch0 = nb * 64;
    const bf16_t* pb = (const bf16_t*)(p.ws + WS_PROJ) + (size_t)b * SEQ * INC;
    bf16_t* hgp = (bf16_t*)(p.ws + WS_OATT) + (size_t)b * SEQ * K2 + AOUT + ch0;
    unsigned char* XR = smem;
    unsigned char* WL = smem + 18432;
    constexpr int LRS = 68;
    float* LA = (float*)(smem + 36864);
    float* LB = (float*)(smem + 36864 + 128 * LRS * 4);
    float* CW = (float*)(smem + 36864 + 2 * 128 * LRS * 4);
    float* CBI = CW + 256; float* BA = CW + 320; float* BX = CW + 384; float* SP = CW + 448;
    float* SEG = CW + 512;
    float* CIN = CW + 1536;
    if (tid < 256) CW[tid] = p.in[I_LCW][(tid >> 6) * D + ch0 + (tid & 63)];
    else if (tid < 320) { const int c = tid - 256; CBI[c] = p.in[I_LCB][ch0 + c]; BA[c] = p.in[I_LBA][ch0 + c]; BX[c] = p.in[I_LBX][ch0 + c]; SP[c] = log1pf(__expf(-p.in[I_LLAM][ch0 + c])); }
    { const bf16_t* wl = (const bf16_t*)(p.ws + WS_WLRU);
      for (int i = tid; i < 1024; i += 512) { const int gsel = i >> 9, rr = (i >> 3) & 63, ch = i & 7;
          *(u32x4*)(WL + gsel * 9216 + rr * 144 + ch * 16) = *(const u32x4*)(wl + gsel * 65536 + nb * 4096 + rr * 64 + ch * 8); } }
    float hprev = 0.f;
    const int tt = tid >> 2, c0 = (tid & 3) * 16;
    u32x4 xa[4][2], gq[2];
#define LRU_LOADX(T0) do { _Pragma("unroll") for (int k = 0; k < 4; ++k) { const int t = (T0) + tt - 3 + k; \
        if (t >= 0) { const bf16_t* xp = pb + (size_t)t * INC + OFF_XL + ch0 + c0; xa[k][0] = *(const u32x4*)xp; xa[k][1] = *(const u32x4*)(xp + 8); } \
        else { xa[k][0] = (u32x4){0u, 0u, 0u, 0u}; xa[k][1] = (u32x4){0u, 0u, 0u, 0u}; } } } while (0)
    LRU_LOADX(0);
    for (int seg = 0; seg < SEQ / 128; ++seg) {
        const int t0 = seg * 128;
        __syncthreads();
        {
            float xr[16];
#pragma unroll
            for (int e = 0; e < 16; ++e) xr[e] = CBI[c0 + e];
#pragma unroll
            for (int k = 0; k < 4; ++k) {
                {   const u32x4 a = xa[k][0], bq = xa[k][1];
                    const float* cw = CW + k * 64 + c0;
                    xr[0] += cw[0] * bflo(a.x); xr[1] += cw[1] * bfhi(a.x); xr[2] += cw[2] * bflo(a.y); xr[3] += cw[3] * bfhi(a.y);
                    xr[4] += cw[4] * bflo(a.z); xr[5] += cw[5] * bfhi(a.z); xr[6] += cw[6] * bflo(a.w); xr[7] += cw[7] * bfhi(a.w);
                    xr[8] += cw[8] * bflo(bq.x); xr[9] += cw[9] * bfhi(bq.x); xr[10] += cw[10] * bflo(bq.y); xr[11] += cw[11] * bfhi(bq.y);
                    xr[12] += cw[12] * bflo(bq.z); xr[13] += cw[13] * bfhi(bq.z); xr[14] += cw[14] * bflo(bq.w); xr[15] += cw[15] * bfhi(bq.w); } }
            u32x4 w0, w1; w0.x = pk2(xr[0], xr[1]); w0.y = pk2(xr[2], xr[3]); w0.z = pk2(xr[4], xr[5]); w0.w = pk2(xr[6], xr[7]);
            w1.x = pk2(xr[8], xr[9]); w1.y = pk2(xr[10], xr[11]); w1.z = pk2(xr[12], xr[13]); w1.w = pk2(xr[14], xr[15]);
            *(u32x4*)(XR + tt * 144 + c0 * 2) = w0; *(u32x4*)(XR + tt * 144 + c0 * 2 + 16) = w1;
#pragma unroll
            for (int q = 0; q < 4; ++q) *(f32x4*)(LB + tt * LRS + c0 + 4 * q) = (f32x4){xr[4 * q], xr[4 * q + 1], xr[4 * q + 2], xr[4 * q + 3]};
            { const bf16_t* gp = pb + (size_t)(t0 + tt) * INC + OFF_LG + ch0 + c0; gq[0] = *(const u32x4*)gp; gq[1] = *(const u32x4*)(gp + 8); }
            if (seg + 1 < SEQ / 128) LRU_LOADX(t0 + 128);
        }
        __syncthreads();
        {
            const unsigned char* ap = XR + (16 * w + fr) * 144 + fq * 16;
            const bf16x8 a0 = *(const bf16x8*)ap, a1 = *(const bf16x8*)(ap + 64);
#pragma unroll
            for (int nt = 0; nt < 4; ++nt) {
                const unsigned char* bp = WL + (16 * nt + fr) * 144 + fq * 16;
                const bf16x8 ba0 = *(const bf16x8*)bp, ba1 = *(const bf16x8*)(bp + 64), bx0 = *(const bf16x8*)(bp + 9216), bx1 = *(const bf16x8*)(bp + 9216 + 64);
                f32x4 ar = (f32x4){0.f, 0.f, 0.f, 0.f}, ax = (f32x4){0.f, 0.f, 0.f, 0.f};
                ar = __builtin_amdgcn_mfma_f32_16x16x32_bf16(a0, ba0, ar, 0, 0, 0); ar = __builtin_amdgcn_mfma_f32_16x16x32_bf16(a1, ba1, ar, 0, 0, 0);
                ax = __builtin_amdgcn_mfma_f32_16x16x32_bf16(a0, bx0, ax, 0, 0, 0); ax = __builtin_amdgcn_mfma_f32_16x16x32_bf16(a1, bx1, ax, 0, 0, 0);
                const int dch = 16 * nt + fr; const float bav = BA[dch], bxv = BX[dch], spv = SP[dch];
#pragma unroll
                for (int e = 0; e < 4; ++e) { const int t = 16 * w + 4 * fq + e;
                    const float rr = sigmoidf_(ar[e] + bav), ii = sigmoidf_(ax[e] + bxv);
                    const float la = -8.0f * rr * spv; const float av = __expf(la);
                    const float xv = LB[t * LRS + dch];
                    LA[t * LRS + dch] = av; LB[t * LRS + dch] = __builtin_amdgcn_sqrtf(fmaxf(1.0f - av * av, 0.f)) * (ii * xv); }
            }
        }
        __syncthreads();
        {
            float hh = 0.f, AA = 1.f;
#pragma unroll
            for (int i = 0; i < 16; ++i) { const int idx = (16 * w + i) * LRS + lane; const float av = LA[idx], bv = LB[idx]; hh = av * hh + bv; AA *= av; LB[idx] = hh; LA[idx] = AA; }
            SEG[(w * 64 + lane) * 2] = AA; SEG[(w * 64 + lane) * 2 + 1] = hh;
        }
        __syncthreads();
        {
            float cin = hprev, mine = 0.f;
#pragma unroll
            for (int s2 = 0; s2 < 8; ++s2) { if (s2 == w) mine = cin; cin = SEG[(s2 * 64 + lane) * 2] * cin + SEG[(s2 * 64 + lane) * 2 + 1]; }
            hprev = cin; CIN[w * 64 + lane] = mine;
        }
        __syncthreads();
        {
            const int s2 = tt >> 4; const int t = t0 + tt;
            const u32x4 g0 = gq[0], g1 = gq[1];
            float hv[16];
#pragma unroll
            for (int q = 0; q < 4; ++q) { const f32x4 lb = *(const f32x4*)(LB + tt * LRS + c0 + 4 * q), la = *(const f32x4*)(LA + tt * LRS + c0 + 4 * q), ci = *(const f32x4*)(CIN + s2 * 64 + c0 + 4 * q);
                const f32x4 hq = lb + la * ci; hv[4 * q] = hq[0]; hv[4 * q + 1] = hq[1]; hv[4 * q + 2] = hq[2]; hv[4 * q + 3] = hq[3]; }
            u32x4 o0, o1;
            o0.x = pk2(hv[0] * gelu_tanh(bflo(g0.x)), hv[1] * gelu_tanh(bfhi(g0.x))); o0.y = pk2(hv[2] * gelu_tanh(bflo(g0.y)), hv[3] * gelu_tanh(bfhi(g0.y)));
            o0.z = pk2(hv[4] * gelu_tanh(bflo(g0.z)), hv[5] * gelu_tanh(bfhi(g0.z))); o0.w = pk2(hv[6] * gelu_tanh(bflo(g0.w)), hv[7] * gelu_tanh(bfhi(g0.w)));
            o1.x = pk2(hv[8] * gelu_tanh(bflo(g1.x)), hv[9] * gelu_tanh(bfhi(g1.x))); o1.y = pk2(hv[10] * gelu_tanh(bflo(g1.y)), hv[11] * gelu_tanh(bfhi(g1.y)));
            o1.z = pk2(hv[12] * gelu_tanh(bflo(g1.z)), hv[13] * gelu_tanh(bfhi(g1.z))); o1.w = pk2(hv[14] * gelu_tanh(bflo(g1.w)), hv[15] * gelu_tanh(bfhi(g1.w)));
            *(u32x4*)(hgp + (size_t)t * K2 + c0) = o0; *(u32x4*)(hgp + (size_t)t * K2 + c0 + 8) = o1;
        }
    }
}

constexpr int N_LRU_ITEMS = CB * 16, N_ATT_ITEMS = CB * 384;
__device__ __forceinline__ void phase_mix(const Params& p, unsigned char* smem, int bid, int G) {
    const int tid = opaque_tid();
    for (int it = bid; it < N_LRU_ITEMS; it += G) { __syncthreads(); lru_item(p, smem, it); }
    const int a0 = (int)(((long)N_ATT_ITEMS * bid) / G), a1 = (int)(((long)N_ATT_ITEMS * (bid + 1)) / G);
    AttnRegs R;
#pragma unroll
    for (int c = 0; c < 4; ++c) { R.k[c] = (u32x4){0u, 0u, 0u, 0u}; R.v[c] = (u32x4){0u, 0u, 0u, 0u}; }
    R.q0 = (bf16x8){0, 0, 0, 0, 0, 0, 0, 0}; R.q1 = R.q0;
    if (a0 < a1) attn_load(p, a0, R, tid);
    float bias[9][4];
#pragma unroll
    for (int t = 0; t < 9; ++t)
#pragma unroll
        for (int e = 0; e < 4; ++e) bias[t][e] = 0.f;
    int gh_tb = -1;
    float* tb = (float*)(smem + 73728);
    const int lane = tid & 63, fr = lane & 15, fq = lane >> 4;
    for (int it = a0; it < a1; ++it) {
        __syncthreads();
        const int gh = (it >> 4) % 24;
        if (gh != gh_tb) {
            const int g = gh >> 3, h = gh & 7, d = (g == 0) ? 1 : (g == 1 ? 4 : 16);
            if (tid < 176) { const int dist0 = 144 - tid; float bv = -1e30f;
                if (dist0 >= 0 && dist0 <= 128) { const int dist = dist0 * d; int bucket;
                    if (dist < 16) bucket = dist; else { const float nf = (float)dist; int lg = 16 + (int)(logf(nf / 16.0f) / 4.852030263919617f * 16.0f); bucket = lg < 31 ? lg : 31; }
                    bv = p.in[I_RELB][bucket * 24 + g * 8 + h]; }
                tb[tid] = bv; }
            __syncthreads();
            const float* rt = tb + 16 + 4 * fq - fr;
#pragma unroll
            for (int t = 0; t < 9; ++t)
#pragma unroll
                for (int e = 0; e < 4; ++e) bias[t][e] = rt[16 * t + e];
            gh_tb = gh;
        }
        attn_compute(p, smem, it, R, it + 1 < a1 ? it + 1 : -1, bias);
    }
}

#define XB_TMO      128
#define XB_XCNT(j)  (256  + 64 * (j))
#define XB_XSUB(j)  (1280 + 64 * (j))
#define XB_XGEN(j)  (2304 + 64 * (j))
#define XB_TOP      3328
#define XB_TOPGEN   3392
#define XCD_BAR_WORDS 3456
#define XB_SPIN_CAP (1u << 22)
__device__ __forceinline__ unsigned xb_ld(unsigned* p)              { return __hip_atomic_load(p, __ATOMIC_RELAXED, __HIP_MEMORY_SCOPE_AGENT); }
__device__ __forceinline__ unsigned xb_add(unsigned* p, unsigned v) { return __hip_atomic_fetch_add(p, v, __ATOMIC_RELAXED, __HIP_MEMORY_SCOPE_AGENT); }
__device__ __forceinline__ unsigned xb_xcc_id() { return (unsigned)__builtin_amdgcn_s_getreg((3 << 11) | 20) & 0xFu; }
#define XB_SPIN(cond, bar) do { unsigned _sp = 0; while (cond) { __builtin_amdgcn_s_sleep(1); \
    if ((++_sp & 255u) == 0u) { if (xb_ld(&(bar)[XB_TMO])) break; if (_sp > XB_SPIN_CAP) { atomicAdd(&(bar)[XB_TMO], 1u); break; } } } } while (0)
struct XcdBarrier { unsigned* bar; unsigned x; volatile LAS unsigned* st; };
__device__ __forceinline__ XcdBarrier xcd_barrier_post(unsigned* bar, volatile LAS unsigned* st) {
    XcdBarrier b; b.bar = bar; b.x = xb_xcc_id(); b.st = st;
    if (threadIdx.x == 0) (void)xb_add(&bar[XB_XCNT(b.x)], 1u);
    return b;
}
__device__ __forceinline__ void xcd_barrier_complete(unsigned* bar, unsigned x, unsigned& nloc, unsigned& nx) {
    const unsigned G = gridDim.x * gridDim.y * gridDim.z;
    unsigned sum, cnt, mine, sp = 0u;
    for (;;) {
        sum = 0u; cnt = 0u; mine = 0u;
#pragma unroll
        for (unsigned j = 0; j < 16; ++j) { const unsigned c = xb_ld(&bar[XB_XCNT(j)]); sum += c; cnt += (c > 0u) ? 1u : 0u; mine = (j == x) ? c : mine; }
        if (sum == G) break;
        __builtin_amdgcn_s_sleep(1);
        if ((++sp & 255u) == 0u) { if (xb_ld(&bar[XB_TMO])) break; if (sp > XB_SPIN_CAP) { atomicAdd(&bar[XB_TMO], 1u); break; } }
    }
    nloc = mine > 0u ? mine : 1u; nx = cnt > 0u ? cnt : 1u;
}
__device__ __forceinline__ void xcd_barrier(const XcdBarrier& b) {
    asm volatile("s_waitcnt vmcnt(0)" ::: "memory");
    __syncthreads();
    if (threadIdx.x == 0) {
        unsigned* bar = b.bar;
        unsigned bx = b.x;
        asm volatile("" : "+s"(bx));
        __builtin_amdgcn_s_waitcnt(0);
        unsigned nloc = b.st[0], nx = b.st[1];
        if (nloc == 0u) { xcd_barrier_complete(bar, bx, nloc, nx); b.st[0] = nloc; b.st[1] = nx; }
        const unsigned old = xb_add(&bar[XB_XSUB(bx)], 1u);
        const unsigned gen = old / nloc;
        if (old + 1u == (gen + 1u) * nloc) {
            __builtin_amdgcn_fence(__ATOMIC_RELEASE, "agent");
            asm volatile("s_waitcnt vmcnt(0)" ::: "memory");
            const unsigned og = xb_add(&bar[XB_TOP], 1u);
            const unsigned tg = og / nx;
            if (og + 1u == (tg + 1u) * nx) xb_add(&bar[XB_TOPGEN], 1u);
            else XB_SPIN(xb_ld(&bar[XB_TOPGEN]) == tg, bar);
            __builtin_amdgcn_fence(__ATOMIC_ACQUIRE, "agent");
            xb_add(&bar[XB_XGEN(bx)], 1u);
            asm volatile("s_waitcnt vmcnt(0)" ::: "memory");
        } else {
            XB_SPIN(xb_ld(&bar[XB_XGEN(bx)]) == gen, bar);
            __builtin_amdgcn_fence(__ATOMIC_ACQUIRE, "agent");
            asm volatile("s_waitcnt vmcnt(0)" ::: "memory");
        }
    }
    __syncthreads();
}

__global__ void __launch_bounds__(512, 2) mega_fwd(Params p) {
    extern __shared__ __attribute__((aligned(16))) unsigned char smem[];
    cg::grid_group grid = cg::this_grid();
    const int G = gridDim.x, bid = blockIdx.x;
    LAS unsigned char* lds = (LAS unsigned char*)smem;
    unsigned char* ws = p.ws;
    unsigned* ctl = (unsigned*)(ws + WS_CTL);

    unsigned nbar = 0;
#if TIMECAT
    unsigned t_last = (unsigned)__builtin_amdgcn_s_memrealtime(), t_acc = 0;
#define STAMP(cat) do { const unsigned _n = (unsigned)__builtin_amdgcn_s_memrealtime(); if ((cat) == TIMECAT) t_acc += _n - t_last; t_last = _n; } while (0)
#else
#define STAMP(cat) do {} while (0)
#endif
#define GSYNC() xcd_barrier(xbar)
    volatile LAS unsigned* xst = (volatile LAS unsigned*)(lds + LDS_BYTES - 64);
    if (threadIdx.x < 2) xst[threadIdx.x] = 0u;
    __syncthreads();
    const XcdBarrier xbar = xcd_barrier_post(ctl + 4096, xst);
    grid.sync();
    phase0(p, smem, bid, G);
    GSYNC(); STAMP(4);
    phase_modx(p, 0, bid, G);
    GSYNC(); STAMP(3);
#pragma unroll 1
    for (int ch = 0; ch < NCH; ++ch) {
        const float* mod = (const float*)(ws + WS_MOD) + (size_t)ch * CB * MOD6;
        {
            pg8::Gemm g{(const bf16_t*)(ws + WS_U), (const bf16_t*)(ws + WS_WIN), MC, INC, D, D}; pg8::StaticOrder S; S.init(MC, INC, G, bid);
            pg8::EpiBf<0> E{(bf16_t*)(ws + WS_PROJ), INC, nullptr, 0, nullptr};
            pg8::gemm_phase<pg8::EpiBf<0>, pg8::StaticOrder, true, true>(lds, g, S, E);
        }
        GSYNC(); STAMP(1);
        phase_mix(p, smem, bid, G);
        GSYNC(); STAMP(2);
        phase_merge(p, bid, G);
        GSYNC(); STAMP(3);
        {
            pg8::Gemm g{(const bf16_t*)(ws + WS_OATT), (const bf16_t*)(ws + WS_WPA), MC, D, K2, K2}; pg8::StaticOrder S; S.init(MC, D, G, bid);
            pg8::EpiMerge E{(bf16_t*)(ws + WS_MRG), (const bf16_t*)(ws + WS_PROJ) + OFF_GA, (const bf16_t*)(ws + WS_PROJ) + OFF_GR, INC};
            pg8::gemm_phase<pg8::EpiMerge, pg8::StaticOrder, true, true>(lds, g, S, E);
        }
        GSYNC(); STAMP(5);
        {
            pg8::Gemm g{(const bf16_t*)(ws + WS_MRG), (const bf16_t*)(ws + WS_WOUT), MC, D, D, D}; pg8::StaticOrder S; S.init(MC, D, G, bid);
            pg8::EpiResid E{(bf16_t*)(ws + WS_YAG), p.in[I_X] + (size_t)ch * MC * D, mod + 2 * D};
            pg8::gemm_phase<pg8::EpiResid, pg8::StaticOrder, true, true>(lds, g, S, E);
        }
        GSYNC(); STAMP(5);
        phase_ln<false>(p, ch, bid, G);
        GSYNC(); STAMP(3);
        {
            pg8::Gemm g{(const bf16_t*)(ws + WS_U), (const bf16_t*)(ws + WS_WUP), MC, FF2, D, D}; pg8::StaticOrder S; S.init(MC, FF2, G, bid);
            pg8::EpiBf<0> E{(bf16_t*)(ws + WS_UP), FF2, nullptr, 0, nullptr};
            pg8::gemm_phase<pg8::EpiBf<0>, pg8::StaticOrder, true, true>(lds, g, S, E);
        }
        GSYNC(); STAMP(1);
        phase_convgate(p, bid, G);
        GSYNC(); STAMP(3);
        {
            pg8::Gemm g{(const bf16_t*)(ws + WS_ACT), (const bf16_t*)(ws + WS_WDN), MC, D, FF, FF}; pg8::StaticOrder S; S.init(MC, D, G, bid);
            pg8::EpiResidLn E{(bf16_t*)(ws + WS_OATT), (const bf16_t*)(ws + WS_YAG), (const float*)(ws + WS_LSE), p.in[I_LN1G], p.in[I_LN1B], mod + 5 * D};
            pg8::gemm_phase<pg8::EpiResidLn, pg8::StaticOrder, true, true>(lds, g, S, E);
        }
        GSYNC(); STAMP(1);
        phase_ln<true>(p, ch, bid, G);
        if (ch + 1 < NCH) { phase_modx(p, ch + 1, bid, G); GSYNC(); STAMP(3); }
    }
#if TIMECAT
    GSYNC(); STAMP(3);
#endif
#if TIMECAT
    if (bid == 0) {
        const int nel = (int)(t_acc / 10);
        for (int i = opaque_tid(); i < nel; i += 512) p.out[(size_t)i * 64 + 7] += 0.125f;
    }
#endif
}

extern "C" void kernel_launch(void* const* d_in, const int* in_sizes, int n_in, void* d_out, int out_size, void* d_ws, size_t ws_size, hipStream_t stream) {
    static int grid = 0;
    if (grid == 0) {
        int dev = 0, cus = 0, per_cu = 0;
        (void)hipGetDevice(&dev);
        (void)hipDeviceGetAttribute(&cus, hipDeviceAttributeMultiprocessorCount, dev);
        if (hipFuncSetAttribute((const void*)mega_fwd, hipFuncAttributeMaxDynamicSharedMemorySize, LDS_BYTES) != hipSuccess) fprintf(stderr, "kernel_launch: hipFuncSetAttribute failed\n");
        if (hipOccupancyMaxActiveBlocksPerMultiprocessor(&per_cu, (const void*)mega_fwd, 512, LDS_BYTES) != hipSuccess || per_cu < 1) { fprintf(stderr, "kernel_launch: occupancy query says %d\n", per_cu); per_cu = 1; }
        (void)hipGetLastError();
        grid = cus * per_cu;
        if (n_in != 24 || ws_size < WS_END) fprintf(stderr, "kernel_launch: unexpected n_in %d / ws_size %zu (need %zu)\n", n_in, ws_size, (size_t)WS_END);
    }
    (void)hipMemsetAsync((char*)d_ws + WS_CTL, 0, CTL_BYTES, stream);
    Params p{};
    for (int i = 0; i < 24; ++i) p.in[i] = (const float*)d_in[i];
    p.out = (float*)d_out; p.ws = (unsigned char*)d_ws;
    void* args[] = {&p};
    hipError_t e = hipLaunchCooperativeKernel((const void*)mega_fwd, dim3(grid), dim3(512), args, LDS_BYTES, stream);
    if (e != hipSuccess) fprintf(stderr, "kernel_launch: cooperative launch failed: %s (grid %d)\n", hipGetErrorString(e), grid);
}
```

```cpp
#include <hip/hip_runtime.h>
#include <hip/hip_cooperative_groups.h>
#include <cstdio>
#include <cstdint>
namespace cg = cooperative_groups;

#define LAS __attribute__((address_space(3)))
typedef unsigned short bf16_t;
typedef short bf16x8 __attribute__((ext_vector_type(8)));
typedef short s16x4 __attribute__((ext_vector_type(4)));
typedef float f32x4 __attribute__((ext_vector_type(4)));
typedef unsigned u32x4 __attribute__((ext_vector_type(4)));
typedef unsigned u32x2 __attribute__((ext_vector_type(2)));

constexpr int D = 1024, NB = 32, SEQ = 2048, MTOT = NB * SEQ;
constexpr int QKV = 1536, INC = 8704, FF = 3072, FF2 = 6144, AOUT = 512;
constexpr int OFF_Q = 0, OFF_K = 1536, OFF_V = 3072, OFF_XL = 4608, OFF_LG = 5632, OFF_GA = 6656, OFF_GR = 7680;
constexpr int CB = 16;
constexpr int MC = CB * SEQ;
constexpr int NCH = NB / CB;
constexpr float ALPHA = 1.189207115002721f;
constexpr float LN_EPS = 1e-5f;
constexpr int MOD6 = 6 * D;
constexpr int K2 = AOUT + D;

constexpr size_t MiB = 1u << 20;
constexpr size_t WS_CTL = 0, CTL_BYTES = 64 * 1024;
constexpr size_t WS_MOD = 1 * MiB;
constexpr size_t WS_WIN = 2 * MiB;
constexpr size_t WS_WPA = WS_WIN + (size_t)INC * D * 2;
constexpr size_t WS_WPL = WS_WPA + (size_t)D * AOUT * 2;
constexpr size_t WS_WOUT = WS_WPL + (size_t)D * D * 2;
constexpr size_t WS_WUP = WS_WOUT + (size_t)D * D * 2;
constexpr size_t WS_WDN = WS_WUP + (size_t)FF2 * D * 2;
constexpr size_t WS_WLRU = WS_WDN + (size_t)D * FF * 2;
constexpr size_t WS_WEND = WS_WLRU + 2 * 16 * 64 * 64 * 2;
static_assert(WS_WEND <= 50 * MiB, "weights region");
constexpr size_t WS_U = 50 * MiB;
constexpr size_t WS_PROJ = WS_U + (size_t)MC * D * 2;
constexpr size_t WS_OG = WS_PROJ + (size_t)MC * INC * 2;
constexpr size_t WS_LSE = WS_OG + (size_t)3 * MC * AOUT * 2;
constexpr size_t WS_OATT = WS_LSE + (size_t)3 * MC * 8 * 4;
constexpr size_t WS_HG = WS_OATT + (size_t)MC * AOUT * 2;
constexpr size_t WS_YAG = WS_HG + (size_t)MC * D * 2;
constexpr size_t WS_MRG = WS_YAG + (size_t)MC * D * 2;
constexpr size_t WS_END = WS_MRG + (size_t)MC * D * 2;
constexpr size_t WS_UP = WS_PROJ;
constexpr size_t WS_ACT = WS_UP + (size_t)MC * FF2 * 2;
static_assert(WS_ACT + (size_t)MC * FF * 2 <= WS_LSE, "UP|ACT overlay must stay inside PROJ|OG");
static_assert(WS_END <= 1024 * MiB, "workspace");

constexpr int LDS_BYTES = 147456;
#ifndef TIMECAT
#define TIMECAT 0
#endif

__device__ __forceinline__ unsigned f2bf(float f) { unsigned u = __builtin_bit_cast(unsigned, f); return (u + 0x7fffu + ((u >> 16) & 1u)) >> 16; }
__device__ __forceinline__ unsigned pk2(float lo, float hi) { unsigned r; asm("v_cvt_pk_bf16_f32 %0, %1, %2" : "=v"(r) : "v"(lo), "v"(hi)); return r; }
__device__ __forceinline__ int opaque_tid() { int t = threadIdx.x; asm volatile("" : "+v"(t)); return t; }
__device__ __forceinline__ float bflo(unsigned u) { return __builtin_bit_cast(float, u << 16); }
__device__ __forceinline__ float bfhi(unsigned u) { return __builtin_bit_cast(float, u & 0xffff0000u); }
__device__ __forceinline__ float sigmoidf_(float x) { return __builtin_amdgcn_rcpf(1.0f + __expf(-x)); }
__device__ __forceinline__ float gelu_tanh(float x) { const float u = 1.5957691216057308f * (x + 0.044715f * x * x * x); return x * sigmoidf_(u); }
__device__ __forceinline__ void swap32(float& a, float& b) { asm volatile("v_nop\n\tv_nop\n\tv_permlane32_swap_b32 %0, %1" : "+v"(a), "+v"(b)); }
__device__ __forceinline__ void swap16(float& a, float& b) { asm volatile("v_nop\n\tv_nop\n\tv_permlane16_swap_b32 %0, %1" : "+v"(a), "+v"(b)); }
__device__ __forceinline__ float quad16_max(float x) {
    { float a = x, b = x; swap32(a, b); x = fmaxf(a, b); }
    { float a = x, b = x; swap16(a, b); x = fmaxf(a, b); }
    return x;
}
__device__ __forceinline__ float quad16_sum(float x) {
    { float a = x, b = x; swap32(a, b); x = a + b; }
    { float a = x, b = x; swap16(a, b); x = a + b; }
    return x;
}
__device__ __forceinline__ float wave_sum(float v) {
#pragma unroll
    for (int o = 1; o < 64; o <<= 1) v += __shfl_xor(v, o);
    return v;
}

namespace pg8 {
constexpr int BM = 256, BK = 64, HALF = 128, HTB = HALF * BK * 2, STAGE_BYTES = 8 * HTB, NXCD = 8, WGM = 8;
__host__ __device__ __forceinline__ int lds_byte(int r, int c) { const int st = (r >> 4) * 2 + (c >> 5), rr = r & 15, cc = c & 31, ob = rr * 64 + cc * 2; return st * 1024 + (ob ^ (((ob >> 9) & 1) << 5)); }
__host__ __device__ __forceinline__ void stage_rc(int b, int& R, int& C) { const int st = b / 1024, sb = b % 1024, swz = sb ^ (((sb >> 9) & 1) << 5); R = (st >> 1) * 16 + swz / 64; C = (st & 1) * 32 + (swz % 64) / 2; }
__host__ __device__ __forceinline__ int perm32(int rho) { const int n = rho >> 4, i = rho & 15; return 8 * (i >> 2) + 4 * n + (i & 3); }

struct Unit { int pm, pn; };
struct Gemm { const bf16_t* A; const bf16_t* Bt; int M, N, K, lda; };

struct StaticOrder {
    int nM, nN, nwg, G, c;
    __device__ void init(int M, int N, int G_, int c_) { nM = M / BM; nN = N / BM; nwg = nM * nN; G = G_; c = c_; }
    __device__ bool next(int i, Unit& u) const {
        const long L = (long)i * G + c; if (L >= nwg) return false;
        int wgid = (int)L; { const int q = nwg / NXCD, r = nwg % NXCD, xcd = wgid % NXCD, off = wgid / NXCD; wgid = (xcd < r ? xcd * (q + 1) : r * (q + 1) + (xcd - r) * q) + off; }
        const int nig = WGM * nN, gid = wgid / nig, fm = gid * WGM, gsz = (nM - fm) < WGM ? (nM - fm) : WGM;
        u.pm = fm + ((wgid % nig) % gsz); u.pn = (wgid % nig) / gsz; return true;
    }
};

template <class Epi, class Sched, bool ALIGN_EPI, bool SP2>
__device__ __forceinline__ void gemm_phase(LAS unsigned char* lds, const Gemm g, const Sched& S, const Epi& E) {
    const int tid = opaque_tid(), wid = __builtin_amdgcn_readfirstlane(tid >> 6), lane = tid & 63, wr = wid >> 2, wc = wid & 3, fr = lane & 15, fq = lane >> 4;
    const int K = g.K, nt = K / BK, lda = g.lda;
    unsigned voffA[2], voffB[2];
#pragma unroll
    for (int i = 0; i < 2; ++i) { int R, C; stage_rc(tid * 16 + i * 8192, R, C); const int Rb = Epi::PERM ? ((R & ~31) + perm32(R & 31)) : R;
        voffA[i] = (unsigned)(R * lda + C) * 2u; voffB[i] = (unsigned)(Rb * K + C) * 2u; }
    const size_t kstep = (size_t)(BK * 2);
    const size_t hstepA = (size_t)HALF * lda * 2, hstepB = (size_t)HALF * K * 2;
    const size_t tstepA = 2 * hstepA, tstepB = 2 * hstepB;
    const unsigned ldsw = (unsigned)wid * 1024u;
    const int aoff = lds_byte(wr * 64 + fr, fq * 8), boff = lds_byte(wc * 32 + fr, fq * 8);
#define PG8_SA(b, h) (((b) * 2 + (h)) * HTB)
#define PG8_SB(b, h) ((4 + (b) * 2 + (h)) * HTB)
#define PG8_STAGE(bufoff, gbase, voff) do { _Pragma("unroll") for (int _i = 0; _i < 2; ++_i) \
        __builtin_amdgcn_global_load_lds((const unsigned*)((const char*)(gbase) + (voff)[_i]), (LAS unsigned*)(lds + (bufoff) + ldsw + _i * 8192), 16, 0, 0); } while (0)
#define PG8_LDA(dst, b, h) do { _Pragma("unroll") for (int m = 0; m < 4; ++m) _Pragma("unroll") for (int k = 0; k < 2; ++k) dst[m][k] = *(const LAS bf16x8*)(lds + PG8_SA(b, h) + aoff + m * 2048 + k * 1024); } while (0)
#define PG8_LDB(dst, b, h) do { _Pragma("unroll") for (int n = 0; n < 2; ++n) _Pragma("unroll") for (int k = 0; k < 2; ++k) dst[n][k] = *(const LAS bf16x8*)(lds + PG8_SB(b, h) + boff + n * 2048 + k * 1024); } while (0)
#define PG8_MMA(ai, bj, At, Bt) do { __builtin_amdgcn_s_setprio(1); _Pragma("unroll") for (int m = 0; m < 4; ++m) _Pragma("unroll") for (int n = 0; n < 2; ++n) _Pragma("unroll") for (int k = 0; k < 2; ++k) \
        acc[ai][bj][m][n] = __builtin_amdgcn_mfma_f32_16x16x32_bf16(Bt[n][k], At[m][k], acc[ai][bj][m][n], 0, 0, 0); __builtin_amdgcn_s_setprio(0); } while (0)
#define PG8_WAIT_V(n) asm volatile("s_waitcnt vmcnt(" #n ")" ::: "memory")
#define PG8_WAIT_L(n) asm volatile("s_waitcnt lgkmcnt(" #n ")" ::: "memory")
#define PG8_BAR __builtin_amdgcn_s_barrier()
#define PG8_SCHED __builtin_amdgcn_sched_barrier(0)
    Unit cur, nxt; int ui = 0;
    if (!S.next(0, cur)) return;
    f32x4 acc[2][2][4][2];
#pragma unroll
    for (int a = 0; a < 2; ++a)
#pragma unroll
        for (int b = 0; b < 2; ++b)
#pragma unroll
            for (int m = 0; m < 4; ++m)
#pragma unroll
                for (int n = 0; n < 2; ++n) acc[a][b][m][n] = (f32x4){0.f, 0.f, 0.f, 0.f};
    bf16x8 At[4][2], B0[2][2], B1[2][2];
    const char* cA = (const char*)g.A + (size_t)cur.pm * tstepA; const char* cB = (const char*)g.Bt + (size_t)cur.pn * tstepB;
    if constexpr (SP2) {
        PG8_STAGE(PG8_SB(0, 0), cB, voffB); PG8_STAGE(PG8_SB(0, 1), cB + hstepB, voffB); PG8_STAGE(PG8_SA(0, 0), cA, voffA); PG8_STAGE(PG8_SA(0, 1), cA + hstepA, voffA);
        if (wr == 1) PG8_BAR;
        PG8_WAIT_V(2); PG8_BAR;
        PG8_STAGE(PG8_SB(1, 0), cB + kstep, voffB); PG8_STAGE(PG8_SA(1, 0), cA + kstep, voffA); PG8_STAGE(PG8_SB(1, 1), cB + hstepB + kstep, voffB);
        PG8_WAIT_V(6); PG8_BAR;
    } else {
        PG8_STAGE(PG8_SB(0, 0), cB, voffB); PG8_STAGE(PG8_SA(0, 0), cA, voffA); PG8_STAGE(PG8_SB(0, 1), cB + hstepB, voffB); PG8_STAGE(PG8_SA(0, 1), cA + hstepA, voffA);
        if (wr == 1) PG8_BAR;
        PG8_WAIT_V(4); PG8_BAR;
        PG8_STAGE(PG8_SB(1, 0), cB + kstep, voffB); PG8_STAGE(PG8_SA(1, 0), cA + kstep, voffA); PG8_STAGE(PG8_SB(1, 1), cB + hstepB + kstep, voffB);
        PG8_WAIT_V(6); PG8_BAR;
    }
    for (;;) {
        const bool has_next = S.next(ui + 1, nxt);
        const char* nA = has_next ? (const char*)g.A + (size_t)nxt.pm * tstepA : cA; const char* nB = has_next ? (const char*)g.Bt + (size_t)nxt.pn * tstepB : cB;
        for (int t = 0; t < nt; t += 2) {
            const bool last = (t == nt - 2);
            const char* a1 = cA + (size_t)(t + 1) * kstep;
            const char* a2 = last ? nA : cA + (size_t)(t + 2) * kstep; const char* b2 = last ? nB : cB + (size_t)(t + 2) * kstep;
            const char* a3 = a2 + kstep; const char* b3 = b2 + kstep;
            if constexpr (Epi::MID_T > 0) { if (t == Epi::MID_T) E.mid(acc, cur, wr, wc, fr, fq); }
            if constexpr (SP2) {
            PG8_LDB(B0, 0, 0); PG8_LDB(B1, 0, 1); PG8_SCHED; PG8_LDA(At, 0, 0); PG8_STAGE(PG8_SA(1, 1), a1 + hstepA, voffA);
            PG8_WAIT_V(8); PG8_WAIT_L(0); PG8_BAR; PG8_MMA(0, 0, At, B0); PG8_MMA(0, 1, At, B1); PG8_BAR; PG8_SCHED;
            PG8_LDA(At, 0, 1); PG8_STAGE(PG8_SB(0, 0), b2, voffB); PG8_STAGE(PG8_SB(0, 1), b2 + hstepB, voffB); PG8_STAGE(PG8_SA(0, 0), a2, voffA);
            PG8_WAIT_V(8); PG8_WAIT_L(0); PG8_BAR; PG8_MMA(1, 0, At, B0); PG8_MMA(1, 1, At, B1); PG8_BAR; PG8_SCHED;
            PG8_LDB(B0, 1, 0); PG8_LDB(B1, 1, 1); PG8_SCHED; PG8_LDA(At, 1, 0); PG8_STAGE(PG8_SA(0, 1), a2 + hstepA, voffA);
            PG8_WAIT_V(8); PG8_WAIT_L(0); PG8_BAR; PG8_MMA(0, 0, At, B0); PG8_MMA(0, 1, At, B1); PG8_BAR; PG8_SCHED;
            PG8_LDA(At, 1, 1); PG8_STAGE(PG8_SB(1, 0), b3, voffB); PG8_STAGE(PG8_SB(1, 1), b3 + hstepB, voffB); PG8_STAGE(PG8_SA(1, 0), a3, voffA);
            PG8_WAIT_V(8); PG8_WAIT_L(0); PG8_BAR; PG8_MMA(1, 0, At, B0); PG8_MMA(1, 1, At, B1); PG8_BAR; PG8_SCHED;
            } else {
            PG8_LDB(B0, 0, 0); PG8_SCHED; PG8_LDA(At, 0, 0); PG8_STAGE(PG8_SA(1, 1), a1 + hstepA, voffA);
            PG8_WAIT_L(8); PG8_BAR; PG8_WAIT_L(0); PG8_MMA(0, 0, At, B0); PG8_BAR; PG8_SCHED;
            PG8_LDB(B1, 0, 1); PG8_STAGE(PG8_SB(0, 0), b2, voffB);
            PG8_BAR; PG8_WAIT_L(0); PG8_MMA(0, 1, At, B1); PG8_BAR;
            PG8_LDA(At, 0, 1); PG8_STAGE(PG8_SA(0, 0), a2, voffA);
            PG8_BAR; PG8_WAIT_L(0); PG8_MMA(1, 0, At, B0); PG8_BAR; PG8_SCHED;
            PG8_STAGE(PG8_SB(0, 1), b2 + hstepB, voffB);
            PG8_WAIT_V(6); PG8_BAR; PG8_MMA(1, 1, At, B1); PG8_BAR;
            PG8_LDB(B0, 1, 0); PG8_SCHED; PG8_LDA(At, 1, 0); PG8_STAGE(PG8_SA(0, 1), a2 + hstepA, voffA);
            PG8_WAIT_L(8); PG8_BAR; PG8_WAIT_L(0); PG8_MMA(0, 0, At, B0); PG8_BAR; PG8_SCHED;
            PG8_LDB(B1, 1, 1); PG8_STAGE(PG8_SB(1, 0), b3, voffB);
            PG8_BAR; PG8_WAIT_L(0); PG8_MMA(0, 1, At, B1); PG8_BAR;
            PG8_LDA(At, 1, 1); PG8_STAGE(PG8_SA(1, 0), a3, voffA);
            PG8_BAR; PG8_WAIT_L(0); PG8_MMA(1, 0, At, B0); PG8_BAR; PG8_SCHED;
            PG8_STAGE(PG8_SB(1, 1), b3 + hstepB, voffB);
            PG8_WAIT_V(6); PG8_BAR; PG8_MMA(1, 1, At, B1); PG8_BAR;
            }
        }
        if constexpr (ALIGN_EPI) { if (wr == 0) PG8_BAR; }
        E(acc, cur, wr, wc, fr, fq);
        if (!has_next) break;
#pragma unroll
        for (int a = 0; a < 2; ++a)
#pragma unroll
            for (int b = 0; b < 2; ++b)
#pragma unroll
                for (int m = 0; m < 4; ++m)
#pragma unroll
                    for (int n = 0; n < 2; ++n) acc[a][b][m][n] = (f32x4){0.f, 0.f, 0.f, 0.f};
        cur = nxt; cA = nA; cB = nB; ++ui;
        if constexpr (ALIGN_EPI) { if (wr == 1) PG8_BAR; }
    }
    PG8_WAIT_V(0);
    if constexpr (!ALIGN_EPI) { if (wr == 0) PG8_BAR; }
    PG8_BAR;
#undef PG8_SA
#undef PG8_SB
#undef PG8_STAGE
#undef PG8_LDA
#undef PG8_LDB
#undef PG8_MMA
#undef PG8_WAIT_V
#undef PG8_WAIT_L
#undef PG8_BAR
#undef PG8_SCHED
}

template <int MODE> struct EpiBf {
    static constexpr bool PERM = true; static constexpr int MID_T = 0;
    bf16_t* O; int ldc; const bf16_t* gate; int ldg; const bf16_t* addend;
    __device__ __forceinline__ void operator()(const f32x4 (&acc)[2][2][4][2], const Unit& u, int wr, int wc, int fr, int fq) const {
        const int row0 = u.pm * BM + wr * 64 + fr, col0 = u.pn * BM + wc * 32 + 8 * fq;
#pragma unroll
        for (int ai = 0; ai < 2; ++ai)
#pragma unroll
            for (int m = 0; m < 4; ++m) { const size_t row = (size_t)(row0 + ai * HALF + m * 16);
#pragma unroll
                for (int bj = 0; bj < 2; ++bj) { f32x4 v0 = acc[ai][bj][m][0], v1 = acc[ai][bj][m][1]; const int col = col0 + bj * HALF;
                    if (MODE >= 1) { const u32x4 gv = *(const u32x4*)(gate + row * ldg + col);
                        v0[0] *= sigmoidf_(bflo(gv.x)); v0[1] *= sigmoidf_(bfhi(gv.x)); v0[2] *= sigmoidf_(bflo(gv.y)); v0[3] *= sigmoidf_(bfhi(gv.y));
                        v1[0] *= sigmoidf_(bflo(gv.z)); v1[1] *= sigmoidf_(bfhi(gv.z)); v1[2] *= sigmoidf_(bflo(gv.w)); v1[3] *= sigmoidf_(bfhi(gv.w)); }
                    if (MODE == 2) { const u32x4 av = *(const u32x4*)(addend + row * ldc + col);
                        v0[0] += bflo(av.x); v0[1] += bfhi(av.x); v0[2] += bflo(av.y); v0[3] += bfhi(av.y);
                        v1[0] += bflo(av.z); v1[1] += bfhi(av.z); v1[2] += bflo(av.w); v1[3] += bfhi(av.w); }
                    u32x4 w; w.x = pk2(v0[0], v0[1]); w.y = pk2(v0[2], v0[3]); w.z = pk2(v1[0], v1[1]); w.w = pk2(v1[2], v1[3]);
                    *(u32x4*)(O + row * ldc + col) = w; } }
    }
};
#define EPI_FENCE() asm volatile("" ::: "memory")
struct EpiMerge {
    static constexpr bool PERM = true; static constexpr int MID_T = AOUT / BK;
    bf16_t* O; const bf16_t* ga; const bf16_t* gr; int ldg;
    __device__ __forceinline__ void mid(f32x4 (&acc)[2][2][4][2], const Unit& u, int wr, int wc, int fr, int fq) const {
        int row0 = u.pm * BM + wr * 64 + fr, col0 = u.pn * BM + wc * 32 + 8 * fq;
        asm volatile("" : "+v"(row0), "+v"(col0));
#pragma unroll
        for (int ah = 0; ah < 4; ++ah) {
            const int ai = ah >> 1, mh = ah & 1;
            u32x4 a[2][2], r[2][2];
#pragma unroll
            for (int mm = 0; mm < 2; ++mm)
#pragma unroll
                for (int bj = 0; bj < 2; ++bj) { const size_t o = (size_t)(row0 + ai * HALF + (2 * mh + mm) * 16) * ldg + col0 + bj * HALF; a[mm][bj] = *(const u32x4*)(ga + o); r[mm][bj] = *(const u32x4*)(gr + o); }
            EPI_FENCE();
#pragma unroll
            for (int mm = 0; mm < 2; ++mm)
#pragma unroll
                for (int bj = 0; bj < 2; ++bj) { const int m = 2 * mh + mm; const u32x4 av = a[mm][bj], rv = r[mm][bj];
                    f32x4& v0 = acc[ai][bj][m][0]; f32x4& v1 = acc[ai][bj][m][1];
                    v0[0] *= sigmoidf_(bflo(av.x)) * (1.0f + __expf(-bflo(rv.x))); v0[1] *= sigmoidf_(bfhi(av.x)) * (1.0f + __expf(-bfhi(rv.x)));
                    v0[2] *= sigmoidf_(bflo(av.y)) * (1.0f + __expf(-bflo(rv.y))); v0[3] *= sigmoidf_(bfhi(av.y)) * (1.0f + __expf(-bfhi(rv.y)));
                    v1[0] *= sigmoidf_(bflo(av.z)) * (1.0f + __expf(-bflo(rv.z))); v1[1] *= sigmoidf_(bfhi(av.z)) * (1.0f + __expf(-bfhi(rv.z)));
                    v1[2] *= sigmoidf_(bflo(av.w)) * (1.0f + __expf(-bflo(rv.w))); v1[3] *= sigmoidf_(bfhi(av.w)) * (1.0f + __expf(-bfhi(rv.w))); }
            EPI_FENCE();
        }
    }
    __device__ __forceinline__ void operator()(const f32x4 (&acc)[2][2][4][2], const Unit& u, int wr, int wc, int fr, int fq) const {
        const int row0 = u.pm * BM + wr * 64 + fr, col0 = u.pn * BM + wc * 32 + 8 * fq;
#pragma unroll
        for (int ah = 0; ah < 4; ++ah) {
            const int ai = ah >> 1, mh = ah & 1;
            u32x4 r[2][2];
#pragma unroll
            for (int mm = 0; mm < 2; ++mm)
#pragma unroll
                for (int bj = 0; bj < 2; ++bj) r[mm][bj] = *(const u32x4*)(gr + (size_t)(row0 + ai * HALF + (2 * mh + mm) * 16) * ldg + col0 + bj * HALF);
            EPI_FENCE();
#pragma unroll
            for (int mm = 0; mm < 2; ++mm)
#pragma unroll
                for (int bj = 0; bj < 2; ++bj) { const int m = 2 * mh + mm; const u32x4 rv = r[mm][bj]; const f32x4 v0 = acc[ai][bj][m][0], v1 = acc[ai][bj][m][1];
                    u32x4 w; w.x = pk2(v0[0] * sigmoidf_(bflo(rv.x)), v0[1] * sigmoidf_(bfhi(rv.x))); w.y = pk2(v0[2] * sigmoidf_(bflo(rv.y)), v0[3] * sigmoidf_(bfhi(rv.y)));
                    w.z = pk2(v1[0] * sigmoidf_(bflo(rv.z)), v1[1] * sigmoidf_(bfhi(rv.z))); w.w = pk2(v1[2] * sigmoidf_(bflo(rv.w)), v1[3] * sigmoidf_(bfhi(rv.w)));
                    *(u32x4*)(O + (size_t)(row0 + ai * HALF + m * 16) * D + col0 + bj * HALF) = w; }
            EPI_FENCE();
        }
    }
};
struct EpiResid {
    static constexpr bool PERM = true; static constexpr int MID_T = 0;
    bf16_t* out; const float* base; const float* gvec;
    __device__ __forceinline__ void operator()(const f32x4 (&acc)[2][2][4][2], const Unit& u, int wr, int wc, int fr, int fq) const {
        const int row0 = u.pm * BM + wr * 64 + fr, col0 = u.pn * BM + wc * 32 + 8 * fq;
        const float* gv = gvec + (size_t)(row0 >> 11) * MOD6 + col0;
        f32x4 g4[2][2];
#pragma unroll
        for (int bj = 0; bj < 2; ++bj)
#pragma unroll
            for (int n = 0; n < 2; ++n) g4[bj][n] = *(const f32x4*)(gv + bj * HALF + 4 * n);
#pragma unroll
        for (int ai = 0; ai < 2; ++ai)
#pragma unroll
            for (int mh = 0; mh < 2; ++mh) {
                f32x4 b[2][2][2];
#pragma unroll
                for (int mm = 0; mm < 2; ++mm)
#pragma unroll
                    for (int bj = 0; bj < 2; ++bj) { const size_t off = (size_t)(row0 + ai * HALF + (2 * mh + mm) * 16) * D + col0 + bj * HALF; b[mm][bj][0] = *(const f32x4*)(base + off); b[mm][bj][1] = *(const f32x4*)(base + off + 4); }
                EPI_FENCE();
#pragma unroll
                for (int mm = 0; mm < 2; ++mm)
#pragma unroll
                    for (int bj = 0; bj < 2; ++bj) { const int m = 2 * mh + mm; const size_t off = (size_t)(row0 + ai * HALF + m * 16) * D + col0 + bj * HALF;
                        const f32x4 v0 = b[mm][bj][0] * ALPHA + g4[bj][0] * acc[ai][bj][m][0], v1 = b[mm][bj][1] * ALPHA + g4[bj][1] * acc[ai][bj][m][1];
                        u32x4 w; w.x = pk2(v0[0], v0[1]); w.y = pk2(v0[2], v0[3]); w.z = pk2(v1[0], v1[1]); w.w = pk2(v1[2], v1[3]);
                        *(u32x4*)(out + off) = w; }
                EPI_FENCE();
            }
    }
};
struct EpiResidLn {
    static constexpr bool PERM = true; static constexpr int MID_T = 0;
    bf16_t* out; const bf16_t* r1; const float* stats; const float* gam; const float* bet; const float* gvec;
    __device__ __forceinline__ void operator()(const f32x4 (&acc)[2][2][4][2], const Unit& u, int wr, int wc, int fr, int fq) const {
        const int row0 = u.pm * BM + wr * 64 + fr, col0 = u.pn * BM + wc * 32 + 8 * fq;
        const float* gv = gvec + (size_t)(row0 >> 11) * MOD6 + col0;
#pragma unroll
        for (int bj = 0; bj < 2; ++bj) {
            f32x4 g4[2], ga[2], be[2];
#pragma unroll
            for (int n = 0; n < 2; ++n) { g4[n] = *(const f32x4*)(gv + bj * HALF + 4 * n); ga[n] = *(const f32x4*)(gam + col0 + bj * HALF + 4 * n) * ALPHA; be[n] = *(const f32x4*)(bet + col0 + bj * HALF + 4 * n) * ALPHA; }
#pragma unroll
            for (int ai = 0; ai < 2; ++ai) {
                u32x4 t[4]; float mean[4], rstd[4];
#pragma unroll
                for (int m = 0; m < 4; ++m) { const int row = row0 + ai * HALF + m * 16; mean[m] = stats[2 * row]; rstd[m] = stats[2 * row + 1]; t[m] = *(const u32x4*)(r1 + (size_t)row * D + col0 + bj * HALF); }
                EPI_FENCE();
#pragma unroll
                for (int m = 0; m < 4; ++m) { const u32x4 tv = t[m];
                    const f32x4 x0 = ((f32x4){bflo(tv.x), bfhi(tv.x), bflo(tv.y), bfhi(tv.y)} - mean[m]) * rstd[m], x1 = ((f32x4){bflo(tv.z), bfhi(tv.z), bflo(tv.w), bfhi(tv.w)} - mean[m]) * rstd[m];
                    const f32x4 v0 = x0 * ga[0] + be[0] + g4[0] * acc[ai][bj][m][0], v1 = x1 * ga[1] + be[1] + g4[1] * acc[ai][bj][m][1];
                    u32x4 w; w.x = pk2(v0[0], v0[1]); w.y = pk2(v0[2], v0[3]); w.z = pk2(v1[0], v1[1]); w.w = pk2(v1[2], v1[3]);
                    *(u32x4*)(out + (size_t)(row0 + ai * HALF + m * 16) * D + col0 + bj * HALF) = w; }
                EPI_FENCE();
            }
        }
    }
};
}

struct Params { const float* in[24]; float* out; unsigned char* ws; };
enum { I_X = 0, I_C, I_WADA, I_BADA, I_WIN, I_RELB, I_LCW, I_LCB, I_LWA, I_LBA, I_LWX, I_LBX, I_LLAM, I_WPA, I_WPL, I_WOUT, I_LN1G, I_LN1B, I_WUP, I_FCW, I_FCB, I_WDN, I_LN2G, I_LN2B };

__device__ __forceinline__ void p0_transpose_item(const float* W, int K, int N, bf16_t* WT, float* scr, int item, int lane, int ldw = 0) {
    if (ldw == 0) ldw = K;
    const int nblk = N / 32, kb = item / nblk, nb = item % nblk, k0 = 64 * kb, n0 = 32 * nb;
#pragma unroll 8
    for (int i = 0; i < 32; ++i) { const int kk = 2 * i + (lane >> 5); scr[kk * 33 + (lane & 31)] = W[(size_t)(k0 + kk) * N + n0 + (lane & 31)]; }
    asm volatile("s_waitcnt lgkmcnt(0)" ::: "memory");
    const int c = lane & 7;
#pragma unroll
    for (int j = 0; j < 4; ++j) { const int n = (lane >> 3) + 8 * j; const float* s = scr + (8 * c) * 33 + n;
        u32x4 o; o.x = pk2(s[0 * 33], s[1 * 33]); o.y = pk2(s[2 * 33], s[3 * 33]); o.z = pk2(s[4 * 33], s[5 * 33]); o.w = pk2(s[6 * 33], s[7 * 33]);
        *(u32x4*)(WT + (size_t)(n0 + n) * ldw + k0 + 8 * c) = o; }
    asm volatile("s_waitcnt lgkmcnt(0)" ::: "memory");
}

__device__ __forceinline__ void phase0(const Params& p, unsigned char* smem, int bid, int G) {
    const int tid = opaque_tid(), lane = tid & 63, wave = tid >> 6;
    unsigned char* ws = p.ws;
    for (int j = bid; j < 192; j += G) {
        float* sc = (float*)smem;
        for (int i = tid; i < NB * D; i += 512) { const int b = i & 31, k = i >> 5; const float v = p.in[I_C][b * D + k]; sc[k * 32 + b] = v / (1.0f + __expf(-v)); }
        __syncthreads();
        const int cl = lane & 31, bh = lane >> 5;
        const float* wp = p.in[I_WADA] + 32 * j + cl;
        f32x4 a0 = (f32x4){0.f, 0.f, 0.f, 0.f}, a1 = a0, a2 = a0, a3 = a0;
#pragma unroll 8
        for (int kk = 0; kk < 128; ++kk) { const int k = 128 * wave + kk; const float wv = wp[(size_t)k * MOD6]; const f32x4* sp = (const f32x4*)(sc + k * 32 + 16 * bh);
            a0 += sp[0] * wv; a1 += sp[1] * wv; a2 += sp[2] * wv; a3 += sp[3] * wv; }
        __syncthreads();
        float* red = (float*)smem;
        { float* rp = red + wave * 1024 + (16 * bh) * 32 + cl;
#pragma unroll
          for (int i = 0; i < 4; ++i) { rp[(i) * 32] = a0[i]; rp[(4 + i) * 32] = a1[i]; rp[(8 + i) * 32] = a2[i]; rp[(12 + i) * 32] = a3[i]; } }
        __syncthreads();
        float* mod = (float*)(ws + WS_MOD);
        for (int o = tid; o < 1024; o += 512) { float sum = 0.f;
#pragma unroll
            for (int w8 = 0; w8 < 8; ++w8) sum += red[w8 * 1024 + o];
            const int b = o >> 5, col = 32 * j + (o & 31); mod[(size_t)b * MOD6 + col] = sum + p.in[I_BADA][col]; }
        __syncthreads();
    }
    float* scr = (float*)(smem + wave * 16384);
    const int gw = bid * 8 + wave, NGW = G * 8;
    constexpr int I_1 = (D / 64) * (INC / 32), I_2 = (AOUT / 64) * (D / 32), I_3 = (D / 64) * (D / 32), I_4 = I_3, I_5 = (D / 64) * (FF2 / 32), I_6 = (FF / 64) * (D / 32), I_7 = 16 * 2;
    constexpr int NIT = I_1 + I_2 + I_3 + I_4 + I_5 + I_6 + 2 * I_7;
    for (int it = gw; it < NIT; it += NGW) {
        int r = it;
        if (r < I_1) { p0_transpose_item(p.in[I_WIN], D, INC, (bf16_t*)(ws + WS_WIN), scr, r, lane); continue; } r -= I_1;
        if (r < I_2) { p0_transpose_item(p.in[I_WPA], AOUT, D, (bf16_t*)(ws + WS_WPA), scr, r, lane, K2); continue; } r -= I_2;
        if (r < I_3) { p0_transpose_item(p.in[I_WPL], D, D, (bf16_t*)(ws + WS_WPA) + AOUT, scr, r, lane, K2); continue; } r -= I_3;
        if (r < I_4) { p0_transpose_item(p.in[I_WOUT], D, D, (bf16_t*)(ws + WS_WOUT), scr, r, lane); continue; } r -= I_4;
        if (r < I_5) { p0_transpose_item(p.in[I_WUP], D, FF2, (bf16_t*)(ws + WS_WUP), scr, r, lane); continue; } r -= I_5;
        if (r < I_6) { p0_transpose_item(p.in[I_WDN], FF, D, (bf16_t*)(ws + WS_WDN), scr, r, lane); continue; } r -= I_6;
        if (r < I_7) { const int blk = r >> 1; p0_transpose_item(p.in[I_LWA] + blk * 4096, 64, 64, (bf16_t*)(ws + WS_WLRU) + blk * 4096, scr, r & 1, lane); continue; } r -= I_7;
        { const int blk = r >> 1; p0_transpose_item(p.in[I_LWX] + blk * 4096, 64, 64, (bf16_t*)(ws + WS_WLRU) + 65536 + blk * 4096, scr, r & 1, lane); }
    }
}

__device__ __forceinline__ void phase_modx(const Params& p, int chunk, int bid, int G) {
    const float* x = p.in[I_X] + (size_t)chunk * MC * D;
    const float* mod = (const float*)(p.ws + WS_MOD) + (size_t)chunk * CB * MOD6;
    bf16_t* U = (bf16_t*)(p.ws + WS_U);
    const int tid = opaque_tid(), c8 = (tid & 127) * 8, rl = tid >> 7;
    for (int tile = bid; tile < MC / 64; tile += G) {
        const int r0 = tile * 64, b = r0 >> 11;
        const float* mp = mod + (size_t)b * MOD6 + c8;
        const f32x4 sh0 = *(const f32x4*)(mp), sh1 = *(const f32x4*)(mp + 4), sc0 = *(const f32x4*)(mp + D) + 1.0f, sc1 = *(const f32x4*)(mp + D + 4) + 1.0f;
#pragma unroll 8
        for (int i = 0; i < 16; ++i) { const size_t off = (size_t)(r0 + rl + 4 * i) * D + c8;
            const f32x4 x0 = *(const f32x4*)(x + off), x1 = *(const f32x4*)(x + off + 4);
            const f32x4 u0 = x0 * sc0 + sh0, u1 = x1 * sc1 + sh1;
            u32x4 w; w.x = pk2(u0[0], u0[1]); w.y = pk2(u0[2], u0[3]); w.z = pk2(u1[0], u1[1]); w.w = pk2(u1[2], u1[3]);
            *(u32x4*)(U + off) = w; }
    }
}

__device__ __forceinline__ void phase_merge(const Params& p, int bid, int G) {
    const bf16_t* og = (const bf16_t*)(p.ws + WS_OG); const float* lse = (const float*)(p.ws + WS_LSE); bf16_t* oa = (bf16_t*)(p.ws + WS_OATT);
    const int nthr = G * 512;
#pragma unroll 2
    for (int i = bid * 512 + opaque_tid(); i < MC * AOUT / 8; i += nthr) {
        const int row = i >> 6, c8 = (i & 63) * 8, h = c8 >> 6;
        const float l0 = lse[(size_t)row * 8 + h], l1 = lse[(size_t)(MC + row) * 8 + h], l2 = lse[(size_t)(2 * MC + row) * 8 + h];
        const float mx = fmaxf(l0, fmaxf(l1, l2));
        float w0 = __expf(l0 - mx), w1 = __expf(l1 - mx), w2 = __expf(l2 - mx);
        const float inv = 1.0f / (w0 + w1 + w2); w0 *= inv; w1 *= inv; w2 *= inv;
        const u32x4 a = *(const u32x4*)(og + (size_t)row * AOUT + c8), b = *(const u32x4*)(og + (size_t)(MC + row) * AOUT + c8), c = *(const u32x4*)(og + (size_t)(2 * MC + row) * AOUT + c8);
        u32x4 o;
        o.x = pk2(w0 * bflo(a.x) + w1 * bflo(b.x) + w2 * bflo(c.x), w0 * bfhi(a.x) + w1 * bfhi(b.x) + w2 * bfhi(c.x));
        o.y = pk2(w0 * bflo(a.y) + w1 * bflo(b.y) + w2 * bflo(c.y), w0 * bfhi(a.y) + w1 * bfhi(b.y) + w2 * bfhi(c.y));
        o.z = pk2(w0 * bflo(a.z) + w1 * bflo(b.z) + w2 * bflo(c.z), w0 * bfhi(a.z) + w1 * bfhi(b.z) + w2 * bfhi(c.z));
        o.w = pk2(w0 * bflo(a.w) + w1 * bflo(b.w) + w2 * bflo(c.w), w0 * bfhi(a.w) + w1 * bfhi(b.w) + w2 * bfhi(c.w));
        *(u32x4*)(oa + (size_t)row * K2 + c8) = o;
    }
}

template <bool SECOND>
__device__ __forceinline__ void phase_ln(const Params& p, int chunk, int bid, int G) {
    const int tid_ = opaque_tid(); const int lane = tid_ & 63, wave = tid_ >> 6;
    float* R = p.out + (size_t)chunk * MC * D;
    const bf16_t* Rb = (const bf16_t*)(p.ws + (SECOND ? WS_OATT : WS_YAG));
    float* stats = (float*)(p.ws + WS_LSE);
    const float* gam = p.in[SECOND ? I_LN2G : I_LN1G]; const float* bet = p.in[SECOND ? I_LN2B : I_LN1B];
    const float* mod = (const float*)(p.ws + WS_MOD) + (size_t)chunk * CB * MOD6;
    bf16_t* U = (bf16_t*)(p.ws + WS_U);
    f32x4 gg[4], bb[4];
#pragma unroll
    for (int j = 0; j < 4; ++j) { gg[j] = *(const f32x4*)(gam + 4 * lane + 256 * j); bb[j] = *(const f32x4*)(bet + 4 * lane + 256 * j); }
    for (int rg = bid * 8 + wave; rg < MC / 16; rg += G * 8) {
        const int rbase = rg * 16, b = rbase >> 11;
        f32x4 sh[4], sc[4];
        if (!SECOND) {
#pragma unroll
            for (int j = 0; j < 4; ++j) { const float* mp = mod + (size_t)b * MOD6 + 4 * lane + 256 * j; sh[j] = *(const f32x4*)(mp + 3 * D); sc[j] = *(const f32x4*)(mp + 4 * D) + 1.0f; } }
#pragma unroll 1
        for (int rr = 0; rr < 16; rr += 2) {
            const int row0 = rbase + rr;
            f32x4 v[2][4]; float s[2] = {0.f, 0.f};
#pragma unroll
            for (int q = 0; q < 2; ++q) { const u32x2* xr = (const u32x2*)(Rb + (size_t)(row0 + q) * D) + lane;
#pragma unroll
                for (int j = 0; j < 4; ++j) { const u32x2 t = xr[64 * j]; v[q][j] = (f32x4){bflo(t.x), bfhi(t.x), bflo(t.y), bfhi(t.y)}; } }
#pragma unroll
            for (int q = 0; q < 2; ++q)
#pragma unroll
                for (int j = 0; j < 4; ++j) s[q] += (v[q][j].x + v[q][j].y) + (v[q][j].z + v[q][j].w);
            const float mean0 = wave_sum(s[0]) * (1.f / D), mean1 = wave_sum(s[1]) * (1.f / D);
            float s2[2] = {0.f, 0.f};
#pragma unroll
            for (int q = 0; q < 2; ++q) { const float mean = q ? mean1 : mean0;
#pragma unroll
                for (int j = 0; j < 4; ++j) { v[q][j] = v[q][j] - mean; s2[q] += (v[q][j].x * v[q][j].x + v[q][j].y * v[q][j].y) + (v[q][j].z * v[q][j].z + v[q][j].w * v[q][j].w); } }
            const float rstd0 = rsqrtf(wave_sum(s2[0]) * (1.f / D) + LN_EPS), rstd1 = rsqrtf(wave_sum(s2[1]) * (1.f / D) + LN_EPS);
            if (!SECOND && lane < 2) { stats[2 * (row0 + lane)] = lane ? mean1 : mean0; stats[2 * (row0 + lane) + 1] = lane ? rstd1 : rstd0; }
#pragma unroll
            for (int j = 0; j < 4; ++j) { const int c = 4 * lane + 256 * j;
#pragma unroll
                for (int q = 0; q < 2; ++q) { const f32x4 y = v[q][j] * (q ? rstd1 : rstd0) * gg[j] + bb[j];
                    if (SECOND) *(f32x4*)(R + (size_t)(row0 + q) * D + c) = y;
                    if (!SECOND) { const f32x4 u = y * sc[j] + sh[j]; u32x2 w; w.x = pk2(u[0], u[1]); w.y = pk2(u[2], u[3]); *(u32x2*)(U + (size_t)(row0 + q) * D + c) = w; } }
            }
        }
    }
}

__device__ __forceinline__ void phase_convgate(const Params& p, int bid, int G) {
    const bf16_t* up = (const bf16_t*)(p.ws + WS_UP); bf16_t* act = (bf16_t*)(p.ws + WS_ACT);
    const float* cw = p.in[I_FCW]; const float* cb = p.in[I_FCB];
    constexpr int RB = 16, NCG = FF / 8;
    const int nthr = G * 512;
    for (int item = bid * 512 + opaque_tid(); item < (MC / RB) * NCG; item += nthr) {
        const int cg = item % NCG, rb = item / NCG, c8 = cg * 8, row0 = rb * RB, t0 = row0 & (SEQ - 1);
        f32x4 wv[3][2], wg[3][2], bv[2], bg[2];
#pragma unroll
        for (int k = 0; k < 3; ++k) { wv[k][0] = *(const f32x4*)(cw + k * FF2 + c8); wv[k][1] = *(const f32x4*)(cw + k * FF2 + c8 + 4);
            wg[k][0] = *(const f32x4*)(cw + k * FF2 + FF + c8); wg[k][1] = *(const f32x4*)(cw + k * FF2 + FF + c8 + 4); }
        bv[0] = *(const f32x4*)(cb + c8); bv[1] = *(const f32x4*)(cb + c8 + 4); bg[0] = *(const f32x4*)(cb + FF + c8); bg[1] = *(const f32x4*)(cb + FF + c8 + 4);
        const bf16_t* rp = up + (size_t)row0 * FF2 + c8;
        u32x4 a2 = (u32x4){0u, 0u, 0u, 0u}, b2 = a2, a1 = a2, b1 = a2;
        if (t0 > 0) { a2 = *(const u32x4*)(rp - 2 * FF2); b2 = *(const u32x4*)(rp - 2 * FF2 + FF); a1 = *(const u32x4*)(rp - FF2); b1 = *(const u32x4*)(rp - FF2 + FF); }
#pragma unroll 4
        for (int i = 0; i < RB; ++i) {
            const u32x4 a0 = *(const u32x4*)(rp + (size_t)i * FF2), b0 = *(const u32x4*)(rp + (size_t)i * FF2 + FF);
            f32x4 v0 = bv[0], v1 = bv[1], g0 = bg[0], g1 = bg[1];
#define CG_ACC(A, B, K) do { \
            v0 += wv[K][0] * (f32x4){bflo(A.x), bfhi(A.x), bflo(A.y), bfhi(A.y)}; v1 += wv[K][1] * (f32x4){bflo(A.z), bfhi(A.z), bflo(A.w), bfhi(A.w)}; \
            g0 += wg[K][0] * (f32x4){bflo(B.x), bfhi(B.x), bflo(B.y), bfhi(B.y)}; g1 += wg[K][1] * (f32x4){bflo(B.z), bfhi(B.z), bflo(B.w), bfhi(B.w)}; } while (0)
            CG_ACC(a2, b2, 0); CG_ACC(a1, b1, 1); CG_ACC(a0, b0, 2);
#undef CG_ACC
            u32x4 o;
            o.x = pk2(gelu_tanh(g0[0]) * v0[0], gelu_tanh(g0[1]) * v0[1]); o.y = pk2(gelu_tanh(g0[2]) * v0[2], gelu_tanh(g0[3]) * v0[3]);
            o.z = pk2(gelu_tanh(g1[0]) * v1[0], gelu_tanh(g1[1]) * v1[1]); o.w = pk2(gelu_tanh(g1[2]) * v1[2], gelu_tanh(g1[3]) * v1[3]);
            *(u32x4*)(act + (size_t)(row0 + i) * FF + c8) = o;
            a2 = a1; b2 = b1; a1 = a0; b1 = b0;
        }
    }
}

typedef short v4i16_t __attribute__((ext_vector_type(4)));
__device__ __forceinline__ s16x4 vtr(const unsigned char* pp) { return __builtin_bit_cast(s16x4, __builtin_amdgcn_ds_read_tr16_b64_v4i16((LAS v4i16_t*)(LAS unsigned char*)pp)); }

struct AttnRegs { u32x4 k[4], v[4]; bf16x8 q0, q1; };
__device__ __forceinline__ void attn_decode(int item, int& b, int& g, int& h, int& d, int& r, int& n) {
    const int sub = item & 15, bgh = item >> 4, bg = bgh >> 3; h = bgh & 7; g = bg % 3; b = bg / 3;
    if (g == 0) { d = 1; r = 0; n = sub; } else if (g == 1) { d = 4; r = sub >> 2; n = sub & 3; } else { d = 16; r = sub; n = 0; }
}
__device__ __forceinline__ void attn_load(const Params& p, int item, AttnRegs& R, int tid) {
    int b, g, h, d, r, n; attn_decode(item, b, g, h, d, r, n);
    const int lane = tid & 63, w = tid >> 6, fr = lane & 15, fq = lane >> 4, hc = (g * 8 + h) * 64;
    const bf16_t* pb = (const bf16_t*)(p.ws + WS_PROJ) + (size_t)b * SEQ * INC;
#pragma unroll
    for (int c = 0; c < 4; ++c) { const int i = tid + 512 * c, j = i >> 3, ch = i & 7;
        R.k[c] = (u32x4){0u, 0u, 0u, 0u}; R.v[c] = (u32x4){0u, 0u, 0u, 0u};
        if (n > 0 || j >= 128) { const int tok = ((n - 1) * 128 + j) * d + r; const bf16_t* q = pb + (size_t)tok * INC + hc + ch * 8; R.k[c] = *(const u32x4*)(q + OFF_K); R.v[c] = *(const u32x4*)(q + OFF_V); } }
    const int qtok = (n * 128 + 16 * w + fr) * d + r;
    const bf16_t* qp = pb + (size_t)qtok * INC + hc + fq * 8;
    R.q0 = *(const bf16x8*)qp; R.q1 = *(const bf16x8*)(qp + 32);
}
__device__ __forceinline__ void attn_compute(const Params& p, unsigned char* smem, int item, AttnRegs& R, int nxt, const float (&bias)[9][4]) {
    const int tid = opaque_tid(), lane = tid & 63, w = tid >> 6, fr = lane & 15, fq = lane >> 4;
    int b, g, h, d, r, n; attn_decode(item, b, g, h, d, r, n);
    unsigned char* Ks = smem; unsigned char* Vs = smem + 36864; float* tb = (float*)(smem + 73728);
#pragma unroll
    for (int c = 0; c < 4; ++c) { const int i = tid + 512 * c, j = i >> 3, ch = i & 7;
        *(u32x4*)(Ks + j * 144 + ch * 16) = R.k[c]; *(u32x4*)(Vs + j * 144 + ch * 16) = R.v[c]; }
    const bf16x8 qf0 = R.q0, qf1 = R.q1;
    const int qtok = (n * 128 + 16 * w + fr) * d + r;
    __syncthreads();
    if (nxt >= 0) attn_load(p, nxt, R, tid);
    f32x4 s[9];
    const int wu = __builtin_amdgcn_readfirstlane(w);
#pragma unroll
    for (int t = 0; t < 9; ++t) {
        const unsigned char* kp = Ks + (16 * (wu + t) + fr) * 144 + fq * 16;
        const bf16x8 k0 = *(const bf16x8*)kp, k1 = *(const bf16x8*)(kp + 64);
        f32x4 z = (f32x4){0.f, 0.f, 0.f, 0.f};
        z = __builtin_amdgcn_mfma_f32_16x16x32_bf16(k0, qf0, z, 0, 0, 0);
        z = __builtin_amdgcn_mfma_f32_16x16x32_bf16(k1, qf1, z, 0, 0, 0);
        const bool live = (n > 0) || (wu + t >= 8);
        f32x4 a;
#pragma unroll
        for (int e = 0; e < 4; ++e) a[e] = z[e] * 0.125f + (live ? bias[t][e] : -1e30f);
        s[t] = a; }
    s16x4 vlo[5][4], vhi[5][4];
#pragma unroll
    for (int pp = 0; pp < 5; ++pp) { const int tA = 2 * pp, tB = (2 * pp + 1 < 9) ? 2 * pp + 1 : 2 * pp;
        const unsigned char* va = Vs + (16 * (wu + tA) + 4 * fq + (fr >> 2)) * 144 + 8 * (fr & 3);
        const unsigned char* vb = Vs + (16 * (wu + tB) + 4 * fq + (fr >> 2)) * 144 + 8 * (fr & 3);
#pragma unroll
        for (int mt = 0; mt < 4; ++mt) { vlo[pp][mt] = vtr(va + 32 * mt); vhi[pp][mt] = vtr(vb + 32 * mt); } }
    float mx = -1e30f;
#pragma unroll
    for (int t = 0; t < 9; ++t)
#pragma unroll
        for (int e = 0; e < 4; ++e) mx = fmaxf(mx, s[t][e]);
    mx = quad16_max(mx);
    float sum = 0.f;
#pragma unroll
    for (int t = 0; t < 9; ++t)
#pragma unroll
        for (int e = 0; e < 4; ++e) { const float pv = __expf(s[t][e] - mx); s[t][e] = pv; sum += pv; }
    sum = quad16_sum(sum);
    f32x4 o[4];
#pragma unroll
    for (int mt = 0; mt < 4; ++mt) o[mt] = (f32x4){0.f, 0.f, 0.f, 0.f};
#pragma unroll
    for (int pp = 0; pp < 5; ++pp) { const int tA = 2 * pp, tB = (2 * pp + 1 < 9) ? 2 * pp + 1 : 2 * pp;
        u32x4 pw; pw.x = pk2(s[tA][0], s[tA][1]); pw.y = pk2(s[tA][2], s[tA][3]);
        if (2 * pp + 1 < 9) { pw.z = pk2(s[tB][0], s[tB][1]); pw.w = pk2(s[tB][2], s[tB][3]); } else { pw.z = 0u; pw.w = 0u; }
        const bf16x8 pf = __builtin_bit_cast(bf16x8, pw);
#pragma unroll
        for (int mt = 0; mt < 4; ++mt) { const s16x4 lo = vlo[pp][mt], hi = vhi[pp][mt];
            bf16x8 vf; vf[0] = lo[0]; vf[1] = lo[1]; vf[2] = lo[2]; vf[3] = lo[3]; vf[4] = hi[0]; vf[5] = hi[1]; vf[6] = hi[2]; vf[7] = hi[3];
            o[mt] = __builtin_amdgcn_mfma_f32_16x16x32_bf16(vf, pf, o[mt], 0, 0, 0); } }
    const float inv = __builtin_amdgcn_rcpf(sum);
    const size_t orow = (size_t)g * MC + (size_t)b * SEQ + qtok;
    bf16_t* op = (bf16_t*)(p.ws + WS_OG) + orow * AOUT + h * 64 + 4 * fq;
#pragma unroll
    for (int mt = 0; mt < 4; ++mt) { u32x2 wv; wv.x = pk2(o[mt][0] * inv, o[mt][1] * inv); wv.y = pk2(o[mt][2] * inv, o[mt][3] * inv); *(u32x2*)(op + 16 * mt) = wv; }
    if (fq == 0) ((float*)(p.ws + WS_LSE))[orow * 8 + h] = mx + __logf(sum);
}

__device__ __forceinline__ void lru_item(const Params& p, unsigned char* smem, int item) {
    const int tid = opaque_tid(), lane = tid & 63, w = tid >> 6, fr = lane & 15, fq = lane >> 4;
    const int b = item >> 4, nb = item & 15, ch0 = nb * 64;
    const bf16_t* pb = (const bf16_t*)(p.ws + WS_PROJ) + (size_t)b * SEQ * INC;
    bf16_t* hgp = (bf16_t*)(p.ws + WS_OATT) + (size_t)b * SEQ * K2 + AOUT + ch0;
    unsigned char* XR = smem;
    unsigned char* WL = smem + 18432;
    constexpr int LRS = 68;
    float* LA = (float*)(smem + 36864);
    float* LB = (float*)(smem + 36864 + 128 * LRS * 4);
    float* CW = (float*)(smem + 36864 + 2 * 128 * LRS * 4);
    float* CBI = CW + 256; float* BA = CW + 320; float* BX = CW + 384; float* SP = CW + 448;
    float* SEG = CW + 512;
    float* CIN = CW + 1536;
    if (tid < 256) CW[tid] = p.in[I_LCW][(tid >> 6) * D + ch0 + (tid & 63)];
    else if (tid < 320) { const int c = tid - 256; CBI[c] = p.in[I_LCB][ch0 + c]; BA[c] = p.in[I_LBA][ch0 + c]; BX[c] = p.in[I_LBX][ch0 + c]; SP[c] = log1pf(__expf(-p.in[I_LLAM][ch0 + c])); }
    { const bf16_t* wl = (const bf16_t*)(p.ws + WS_WLRU);
      for (int i = tid; i < 1024; i += 512) { const int gsel = i >> 9, rr = (i >> 3) & 63, ch = i & 7;
          *(u32x4*)(WL + gsel * 9216 + rr * 144 + ch * 16) = *(const u32x4*)(wl + gsel * 65536 + nb * 4096 + rr * 64 + ch * 8); } }
    float hprev = 0.f;
    const int tt = tid >> 2, c0 = (tid & 3) * 16;
    u32x4 xa[4][2], gq[2];
#define LRU_LOADX(T0) do { _Pragma("unroll") for (int k = 0; k < 4; ++k) { const int t = (T0) + tt - 3 + k; \
        if (t >= 0) { const bf16_t* xp = pb + (size_t)t * INC + OFF_XL + ch0 + c0; xa[k][0] = *(const u32x4*)xp; xa[k][1] = *(const u32x4*)(xp + 8); } \
        else { xa[k][0] = (u32x4){0u, 0u, 0u, 0u}; xa[k][1] = (u32x4){0u, 0u, 0u, 0u}; } } } while (0)
    LRU_LOADX(0);
    for (int seg = 0; seg < SEQ / 128; ++seg) {
        const int t0 = seg * 128;
        __syncthreads();
        {
            float xr[16];
#pragma unroll
            for (int e = 0; e < 16; ++e) xr[e] = CBI[c0 + e];
#pragma unroll
            for (int k = 0; k < 4; ++k) {
                {   const u32x4 a = xa[k][0], bq = xa[k][1];
                    const float* cw = CW + k * 64 + c0;
                    xr[0] += cw[0] * bflo(a.x); xr[1] += cw[1] * bfhi(a.x); xr[2] += cw[2] * bflo(a.y); xr[3] += cw[3] * bfhi(a.y);
                    xr[4] += cw[4] * bflo(a.z); xr[5] += cw[5] * bfhi(a.z); xr[6] += cw[6] * bflo(a.w); xr[7] += cw[7] * bfhi(a.w);
                    xr[8] += cw[8] * bflo(bq.x); xr[9] += cw[9] * bfhi(bq.x); xr[10] += cw[10] * bflo(bq.y); xr[11] += cw[11] * bfhi(bq.y);
                    xr[12] += cw[12] * bflo(bq.z); xr[13] += cw[13] * bfhi(bq.z); xr[14] += cw[14] * bflo(bq.w); xr[15] += cw[15] * bfhi(bq.w); } }
            u32x4 w0, w1; w0.x = pk2(xr[0], xr[1]); w0.y = pk2(xr[2], xr[3]); w0.z = pk2(xr[4], xr[5]); w0.w = pk2(xr[6], xr[7]);
            w1.x = pk2(xr[8], xr[9]); w1.y = pk2(xr[10], xr[11]); w1.z = pk2(xr[12], xr[13]); w1.w = pk2(xr[14], xr[15]);
            *(u32x4*)(XR + tt * 144 + c0 * 2) = w0; *(u32x4*)(XR + tt * 144 + c0 * 2 + 16) = w1;
#pragma unroll
            for (int q = 0; q < 4; ++q) *(f32x4*)(LB + tt * LRS + c0 + 4 * q) = (f32x4){xr[4 * q], xr[4 * q + 1], xr[4 * q + 2], xr[4 * q + 3]};
            { const bf16_t* gp = pb + (size_t)(t0 + tt) * INC + OFF_LG + ch0 + c0; gq[0] = *(const u32x4*)gp; gq[1] = *(const u32x4*)(gp + 8); }
            if (seg + 1 < SEQ / 128) LRU_LOADX(t0 + 128);
        }
        __syncthreads();
        {
            const unsigned char* ap = XR + (16 * w + fr) * 144 + fq * 16;
            const bf16x8 a0 = *(const bf16x8*)ap, a1 = *(const bf16x8*)(ap + 64);
#pragma unroll
            for (int nt = 0; nt < 4; ++nt) {
                const unsigned char* bp = WL + (16 * nt + fr) * 144 + fq * 16;
                const bf16x8 ba0 = *(const bf16x8*)bp, ba1 = *(const bf16x8*)(bp + 64), bx0 = *(const bf16x8*)(bp + 9216), bx1 = *(const bf16x8*)(bp + 9216 + 64);
                f32x4 ar = (f32x4){0.f, 0.f, 0.f, 0.f}, ax = (f32x4){0.f, 0.f, 0.f, 0.f};
                ar = __builtin_amdgcn_mfma_f32_16x16x32_bf16(a0, ba0, ar, 0, 0, 0); ar = __builtin_amdgcn_mfma_f32_16x16x32_bf16(a1, ba1, ar, 0, 0, 0);
                ax = __builtin_amdgcn_mfma_f32_16x16x32_bf16(a0, bx0, ax, 0, 0, 0); ax = __builtin_amdgcn_mfma_f32_16x16x32_bf16(a1, bx1, ax, 0, 0, 0);
                const int dch = 16 * nt + fr; const float bav = BA[dch], bxv = BX[dch], spv = SP[dch];
#pragma unroll
                for (int e = 0; e < 4; ++e) { const int t = 16 * w + 4 * fq + e;
                    const float rr = sigmoidf_(ar[e] + bav), ii = sigmoidf_(ax[e] + bxv);
                    const float la = -8.0f * rr * spv; const float av = __expf(la);
                    const float xv = LB[t * LRS + dch];
                    LA[t * LRS + dch] = av; LB[t * LRS + dch] = __builtin_amdgcn_sqrtf(fmaxf(1.0f - av * av, 0.f)) * (ii * xv); }
            }
        }
        __syncthreads();
        {
            float hh = 0.f, AA = 1.f;
#pragma unroll
            for (int i = 0; i < 16; ++i) { const int idx = (16 * w + i) * LRS + lane; const float av = LA[idx], bv = LB[idx]; hh = av * hh + bv; AA *= av; LB[idx] = hh; LA[idx] = AA; }
            SEG[(w * 64 + lane) * 2] = AA; SEG[(w * 64 + lane) * 2 + 1] = hh;
        }
        __syncthreads();
        {
            float cin = hprev, mine = 0.f;
#pragma unroll
            for (int s2 = 0; s2 < 8; ++s2) { if (s2 == w) mine = cin; cin = SEG[(s2 * 64 + lane) * 2] * cin + SEG[(s2 * 64 + lane) * 2 + 1]; }
            hprev = cin; CIN[w * 64 + lane] = mine;
        }
        __syncthreads();
        {
            const int s2 = tt >> 4; const int t = t0 + tt;
            const u32x4 g0 = gq[0], g1 = gq[1];
            float hv[16];
#pragma unroll
            for (int q = 0; q < 4; ++q) { const f32x4 lb = *(const f32x4*)(LB + tt * LRS + c0 + 4 * q), la = *(const f32x4*)(LA + tt * LRS + c0 + 4 * q), ci = *(const f32x4*)(CIN + s2 * 64 + c0 + 4 * q);
                const f32x4 hq = lb + la * ci; hv[4 * q] = hq[0]; hv[4 * q + 1] = hq[1]; hv[4 * q + 2] = hq[2]; hv[4 * q + 3] = hq[3]; }
            u32x4 o0, o1;
            o0.x = pk2(hv[0] * gelu_tanh(bflo(g0.x)), hv[1] * gelu_tanh(bfhi(g0.x))); o0.y = pk2(hv[2] * gelu_tanh(bflo(g0.y)), hv[3] * gelu_tanh(bfhi(g0.y)));
            o0.z = pk2(hv[4] * gelu_tanh(bflo(g0.z)), hv[5] * gelu_tanh(bfhi(g0.z))); o0.w = pk2(hv[6] * gelu_tanh(bflo(g0.w)), hv[7] * gelu_tanh(bfhi(g0.w)));
            o1.x = pk2(hv[8] * gelu_tanh(bflo(g1.x)), hv[9] * gelu_tanh(bfhi(g1.x))); o1.y = pk2(hv[10] * gelu_tanh(bflo(g1.y)), hv[11] * gelu_tanh(bfhi(g1.y)));
            o1.z = pk2(hv[12] * gelu_tanh(bflo(g1.z)), hv[13] * gelu_tanh(bfhi(g1.z))); o1.w = pk2(hv[14] * gelu_tanh(bflo(g1.w)), hv[15] * gelu_tanh(bfhi(g1.w)));
            *(u32x4*)(hgp + (size_t)t * K2 + c0) = o0; *(u32x4*)(hgp + (size_t)t * K2 + c0 + 8) = o1;
        }
    }
}

constexpr int N_LRU_ITEMS = CB * 16, N_ATT_ITEMS = CB * 384;
__device__ __forceinline__ void phase_mix(const Params& p, unsigned char* smem, int bid, int G) {
    const int tid = opaque_tid();
    for (int it = bid; it < N_LRU_ITEMS; it += G) { __syncthreads(); lru_item(p, smem, it); }
    const int a0 = (int)(((long)N_ATT_ITEMS * bid) / G), a1 = (int)(((long)N_ATT_ITEMS * (bid + 1)) / G);
    AttnRegs R;
#pragma unroll
    for (int c = 0; c < 4; ++c) { R.k[c] = (u32x4){0u, 0u, 0u, 0u}; R.v[c] = (u32x4){0u, 0u, 0u, 0u}; }
    R.q0 = (bf16x8){0, 0, 0, 0, 0, 0, 0, 0}; R.q1 = R.q0;
    if (a0 < a1) attn_load(p, a0, R, tid);
    float bias[9][4];
#pragma unroll
    for (int t = 0; t < 9; ++t)
#pragma unroll
        for (int e = 0; e < 4; ++e) bias[t][e] = 0.f;
    int gh_tb = -1;
    float* tb = (float*)(smem + 73728);
    const int lane = tid & 63, fr = lane & 15, fq = lane >> 4;
    for (int it = a0; it < a1; ++it) {
        __syncthreads();
        const int gh = (it >> 4) % 24;
        if (gh != gh_tb) {
            const int g = gh >> 3, h = gh & 7, d = (g == 0) ? 1 : (g == 1 ? 4 : 16);
            if (tid < 176) { const int dist0 = 144 - tid; float bv = -1e30f;
                if (dist0 >= 0 && dist0 <= 128) { const int dist = dist0 * d; int bucket;
                    if (dist < 16) bucket = dist; else { const float nf = (float)dist; int lg = 16 + (int)(logf(nf / 16.0f) / 4.852030263919617f * 16.0f); bucket = lg < 31 ? lg : 31; }
                    bv = p.in[I_RELB][bucket * 24 + g * 8 + h]; }
                tb[tid] = bv; }
            __syncthreads();
            const float* rt = tb + 16 + 4 * fq - fr;
#pragma unroll
            for (int t = 0; t < 9; ++t)
#pragma unroll
                for (int e = 0; e < 4; ++e) bias[t][e] = rt[16 * t + e];
            gh_tb = gh;
        }
        attn_compute(p, smem, it, R, it + 1 < a1 ? it + 1 : -1, bias);
    }
}

#define XB_TMO      128
#define XB_XCNT(j)  (256  + 64 * (j))
#define XB_XSUB(j)  (1280 + 64 * (j))
#define XB_XGEN(j)  (2304 + 64 * (j))
#define XB_TOP      3328
#define XB_TOPGEN   3392
#define XCD_BAR_WORDS 3456
#define XB_SPIN_CAP (1u << 22)
__device__ __forceinline__ unsigned xb_ld(unsigned* p)              { return __hip_atomic_load(p, __ATOMIC_RELAXED, __HIP_MEMORY_SCOPE_AGENT); }
__device__ __forceinline__ unsigned xb_add(unsigned* p, unsigned v) { return __hip_atomic_fetch_add(p, v, __ATOMIC_RELAXED, __HIP_MEMORY_SCOPE_AGENT); }
__device__ __forceinline__ unsigned xb_xcc_id() { return (unsigned)__builtin_amdgcn_s_getreg((3 << 11) | 20) & 0xFu; }
#define XB_SPIN(cond, bar) do { unsigned _sp = 0; while (cond) { __builtin_amdgcn_s_sleep(1); \
    if ((++_sp & 255u) == 0u) { if (xb_ld(&(bar)[XB_TMO])) break; if (_sp > XB_SPIN_CAP) { atomicAdd(&(bar)[XB_TMO], 1u); break; } } } } while (0)
struct XcdBarrier { unsigned* bar; unsigned x; volatile LAS unsigned* st; };
__device__ __forceinline__ XcdBarrier xcd_barrier_post(unsigned* bar, volatile LAS unsigned* st) {
    XcdBarrier b; b.bar = bar; b.x = xb_xcc_id(); b.st = st;
    if (threadIdx.x == 0) (void)xb_add(&bar[XB_XCNT(b.x)], 1u);
    return b;
}
__device__ __forceinline__ void xcd_barrier_complete(unsigned* bar, unsigned x, unsigned& nloc, unsigned& nx) {
    const unsigned G = gridDim.x * gridDim.y * gridDim.z;
    unsigned sum, cnt, mine, sp = 0u;
    for (;;) {
        sum = 0u; cnt = 0u; mine = 0u;
#pragma unroll
        for (unsigned j = 0; j < 16; ++j) { const unsigned c = xb_ld(&bar[XB_XCNT(j)]); sum += c; cnt += (c > 0u) ? 1u : 0u; mine = (j == x) ? c : mine; }
        if (sum == G) break;
        __builtin_amdgcn_s_sleep(1);
        if ((++sp & 255u) == 0u) { if (xb_ld(&bar[XB_TMO])) break; if (sp > XB_SPIN_CAP) { atomicAdd(&bar[XB_TMO], 1u); break; } }
    }
    nloc = mine > 0u ? mine : 1u; nx = cnt > 0u ? cnt : 1u;
}
__device__ __forceinline__ void xcd_barrier(const XcdBarrier& b) {
    asm volatile("s_waitcnt vmcnt(0)" ::: "memory");
    __syncthreads();
    if (threadIdx.x == 0) {
        unsigned* bar = b.bar;
        unsigned bx = b.x;
        asm volatile("" : "+s"(bx));
        __builtin_amdgcn_s_waitcnt(0);
        unsigned nloc = b.st[0], nx = b.st[1];
        if (nloc == 0u) { xcd_barrier_complete(bar, bx, nloc, nx); b.st[0] = nloc; b.st[1] = nx; }
        const unsigned old = xb_add(&bar[XB_XSUB(bx)], 1u);
        const unsigned gen = old / nloc;
        if (old + 1u == (gen + 1u) * nloc) {
            __builtin_amdgcn_fence(__ATOMIC_RELEASE, "agent");
            asm volatile("s_waitcnt vmcnt(0)" ::: "memory");
            const unsigned og = xb_add(&bar[XB_TOP], 1u);
            const unsigned tg = og / nx;
            if (og + 1u == (tg + 1u) * nx) xb_add(&bar[XB_TOPGEN], 1u);
            else XB_SPIN(xb_ld(&bar[XB_TOPGEN]) == tg, bar);
            __builtin_amdgcn_fence(__ATOMIC_ACQUIRE, "agent");
            xb_add(&bar[XB_XGEN(bx)], 1u);
            asm volatile("s_waitcnt vmcnt(0)" ::: "memory");
        } else {
            XB_SPIN(xb_ld(&bar[XB_XGEN(bx)]) == gen, bar);
            __builtin_amdgcn_fence(__ATOMIC_ACQUIRE, "agent");
            asm volatile("s_waitcnt vmcnt(0)" ::: "memory");
        }
    }
    __syncthreads();
}

__global__ void __launch_bounds__(512, 2) mega_fwd(Params p) {
    extern __shared__ __attribute__((aligned(16))) unsigned char smem[];
    cg::grid_group grid = cg::this_grid();
    const int G = gridDim.x, bid = blockIdx.x;
    LAS unsigned char* lds = (LAS unsigned char*)smem;
    unsigned char* ws = p.ws;
    unsigned* ctl = (unsigned*)(ws + WS_CTL);

    unsigned nbar = 0;
#if TIMECAT
    unsigned t_last = (unsigned)__builtin_amdgcn_s_memrealtime(), t_acc = 0;
#define STAMP(cat) do { const unsigned _n = (unsigned)__builtin_amdgcn_s_memrealtime(); if ((cat) == TIMECAT) t_acc += _n - t_last; t_last = _n; } while (0)
#else
#define STAMP(cat) do {} while (0)
#endif
#define GSYNC() xcd_barrier(xbar)
    volatile LAS unsigned* xst = (volatile LAS unsigned*)(lds + LDS_BYTES - 64);
    if (threadIdx.x < 2) xst[threadIdx.x] = 0u;
    __syncthreads();
    const XcdBarrier xbar = xcd_barrier_post(ctl + 4096, xst);
    grid.sync();
    phase0(p, smem, bid, G);
    GSYNC(); STAMP(4);
    phase_modx(p, 0, bid, G);
    GSYNC(); STAMP(3);
#pragma unroll 1
    for (int ch = 0; ch < NCH; ++ch) {
        const float* mod = (const float*)(ws + WS_MOD) + (size_t)ch * CB * MOD6;
        {
            pg8::Gemm g{(const bf16_t*)(ws + WS_U), (const bf16_t*)(ws + WS_WIN), MC, INC, D, D}; pg8::StaticOrder S; S.init(MC, INC, G, bid);
            pg8::EpiBf<0> E{(bf16_t*)(ws + WS_PROJ), INC, nullptr, 0, nullptr};
            pg8::gemm_phase<pg8::EpiBf<0>, pg8::StaticOrder, true, true>(lds, g, S, E);
        }
        GSYNC(); STAMP(1);
        phase_mix(p, smem, bid, G);
        GSYNC(); STAMP(2);
        phase_merge(p, bid, G);
        GSYNC(); STAMP(3);
        {
            pg8::Gemm g{(const bf16_t*)(ws + WS_OATT), (const bf16_t*)(ws + WS_WPA), MC, D, K2, K2}; pg8::StaticOrder S; S.init(MC, D, G, bid);
            pg8::EpiMerge E{(bf16_t*)(ws + WS_MRG), (const bf16_t*)(ws + WS_PROJ) + OFF_GA, (const bf16_t*)(ws + WS_PROJ) + OFF_GR, INC};
            pg8::gemm_phase<pg8::EpiMerge, pg8::StaticOrder, true, true>(lds, g, S, E);
        }
        GSYNC(); STAMP(5);
        {
            pg8::Gemm g{(const bf16_t*)(ws + WS_MRG), (const bf16_t*)(ws + WS_WOUT), MC, D, D, D}; pg8::StaticOrder S; S.init(MC, D, G, bid);
            pg8::EpiResid E{(bf16_t*)(ws + WS_YAG), p.in[I_X] + (size_t)ch * MC * D, mod + 2 * D};
            pg8::gemm_phase<pg8::EpiResid, pg8::StaticOrder, true, true>(lds, g, S, E);
        }
        GSYNC(); STAMP(5);
        phase_ln<false>(p, ch, bid, G);
        GSYNC(); STAMP(3);
        {
            pg8::Gemm g{(const bf16_t*)(ws + WS_U), (const bf16_t*)(ws + WS_WUP), MC, FF2, D, D}; pg8::StaticOrder S; S.init(MC, FF2, G, bid);
            pg8::EpiBf<0> E{(bf16_t*)(ws + WS_UP), FF2, nullptr, 0, nullptr};
            pg8::gemm_phase<pg8::EpiBf<0>, pg8::StaticOrder, true, true>(lds, g, S, E);
        }
        GSYNC(); STAMP(1);
        phase_convgate(p, bid, G);
        GSYNC(); STAMP(3);
        {
            pg8::Gemm g{(const bf16_t*)(ws + WS_ACT), (const bf16_t*)(ws + WS_WDN), MC, D, FF, FF}; pg8::StaticOrder S; S.init(MC, D, G, bid);
            pg8::EpiResidLn E{(bf16_t*)(ws + WS_OATT), (const bf16_t*)(ws + WS_YAG), (const float*)(ws + WS_LSE), p.in[I_LN1G], p.in[I_LN1B], mod + 5 * D};
            pg8::gemm_phase<pg8::EpiResidLn, pg8::StaticOrder, true, true>(lds, g, S, E);
        }
        GSYNC(); STAMP(1);
        phase_ln<true>(p, ch, bid, G);
        if (ch + 1 < NCH) { phase_modx(p, ch + 1, bid, G); GSYNC(); STAMP(3); }
    }
#if TIMECAT
    GSYNC(); STAMP(3);
#endif
#if TIMECAT
    if (bid == 0) {
        const int nel = (int)(t_acc / 10);
        for (int i = opaque_tid(); i < nel; i += 512) p.out[(size_t)i * 64 + 7] += 0.125f;
    }
#endif
}

extern "C" void kernel_launch(void* const* d_in, const int* in_sizes, int n_in, void* d_out, int out_size, void* d_ws, size_t ws_size, hipStream_t stream) {
    static int grid = 0;
    if (grid == 0) {
        int dev = 0, cus = 0, per_cu = 0;
        (void)hipGetDevice(&dev);
        (void)hipDeviceGetAttribute(&cus, hipDeviceAttributeMultiprocessorCount, dev);
        if (hipFuncSetAttribute((const void*)mega_fwd, hipFuncAttributeMaxDynamicSharedMemorySize, LDS_BYTES) != hipSuccess) fprintf(stderr, "kernel_launch: hipFuncSetAttribute failed\n");
        if (hipOccupancyMaxActiveBlocksPerMultiprocessor(&per_cu, (const void*)mega_fwd, 512, LDS_BYTES) != hipSuccess || per_cu < 1) { fprintf(stderr, "kernel_launch: occupancy query says %d\n", per_cu); per_cu = 1; }
        (void)hipGetLastError();
        grid = cus * per_cu;
        if (n_in != 24 || ws_size < WS_END) fprintf(stderr, "kernel_launch: unexpected n_in %d / ws_size %zu (need %zu)\n", n_in, ws_size, (size_t)WS_END);
    }
    (void)hipMemsetAsync((char*)d_ws + WS_CTL, 0, CTL_BYTES, stream);
    Params p{};
    for (int i = 0; i < 24; ++i) p.in[i] = (const float*)d_in[i];
    p.out = (float*)d_out; p.ws = (unsigned char*)d_ws;
    void* args[] = {&p};
    hipError_t e = hipLaunchCooperativeKernel((const void*)mega_fwd, dim3(grid), dim3(512), args, LDS_BYTES, stream);
    if (e != hipSuccess) fprintf(stderr, "kernel_launch: cooperative launch failed: %s (grid %d)\n", hipGetErrorString(e), grid);
}
```

```cpp
#include <hip/hip_runtime.h>
#include <hip/hip_cooperative_groups.h>
#include <cstdio>
#include <cstdint>
namespace cg = cooperative_groups;

#define LAS __attribute__((address_space(3)))
typedef unsigned short bf16_t;
typedef short bf16x8 __attribute__((ext_vector_type(8)));
typedef short s16x4 __attribute__((ext_vector_type(4)));
typedef float f32x4 __attribute__((ext_vector_type(4)));
typedef unsigned u32x4 __attribute__((ext_vector_type(4)));
typedef unsigned u32x2 __attribute__((ext_vector_type(2)));

constexpr int D = 1024, NB = 32, SEQ = 2048, MTOT = NB * SEQ;
constexpr int QKV = 1536, INC = 8704, FF = 3072, FF2 = 6144, AOUT = 512;
constexpr int OFF_Q = 0, OFF_K = 1536, OFF_V = 3072, OFF_XL = 4608, OFF_LG = 5632, OFF_GA = 6656, OFF_GR = 7680;
constexpr int CB = 16;
constexpr int MC = CB * SEQ;
constexpr int NCH = NB / CB;
constexpr float ALPHA = 1.189207115002721f;
constexpr float LN_EPS = 1e-5f;
constexpr int MOD6 = 6 * D;
constexpr int K2 = AOUT + D;

constexpr size_t MiB = 1u << 20;
constexpr size_t WS_CTL = 0, CTL_BYTES = 64 * 1024;
constexpr size_t WS_MOD = 1 * MiB;
constexpr size_t WS_WIN = 2 * MiB;
constexpr size_t WS_WPA = WS_WIN + (size_t)INC * D * 2;
constexpr size_t WS_WPL = WS_WPA + (size_t)D * AOUT * 2;
constexpr size_t WS_WOUT = WS_WPL + (size_t)D * D * 2;
constexpr size_t WS_WUP = WS_WOUT + (size_t)D * D * 2;
constexpr size_t WS_WDN = WS_WUP + (size_t)FF2 * D * 2;
constexpr size_t WS_WLRU = WS_WDN + (size_t)D * FF * 2;
constexpr size_t WS_WEND = WS_WLRU + 2 * 16 * 64 * 64 * 2;
static_assert(WS_WEND <= 50 * MiB, "weights region");
constexpr size_t WS_U = 50 * MiB;
constexpr size_t WS_PROJ = WS_U + (size_t)MC * D * 2;
constexpr size_t WS_OG = WS_PROJ + (size_t)MC * INC * 2;
constexpr size_t WS_LSE = WS_OG + (size_t)3 * MC * AOUT * 2;
constexpr size_t WS_OATT = WS_LSE + (size_t)3 * MC * 8 * 4;
constexpr size_t WS_HG = WS_OATT + (size_t)MC * AOUT * 2;
constexpr size_t WS_YAG = WS_HG + (size_t)MC * D * 2;
constexpr size_t WS_MRG = WS_YAG + (size_t)MC * D * 2;
constexpr size_t WS_END = WS_MRG + (size_t)MC * D * 2;
constexpr size_t WS_UP = WS_PROJ;
constexpr size_t WS_ACT = WS_UP + (size_t)MC * FF2 * 2;
static_assert(WS_ACT + (size_t)MC * FF * 2 <= WS_LSE, "UP|ACT overlay must stay inside PROJ|OG");
static_assert(WS_END <= 1024 * MiB, "workspace");

constexpr int LDS_BYTES = 147456;
#ifndef TIMECAT
#define TIMECAT 0
#endif

__device__ __forceinline__ unsigned f2bf(float f) { unsigned u = __builtin_bit_cast(unsigned, f); return (u + 0x7fffu + ((u >> 16) & 1u)) >> 16; }
__device__ __forceinline__ unsigned pk2(float lo, float hi) { unsigned r; asm("v_cvt_pk_bf16_f32 %0, %1, %2" : "=v"(r) : "v"(lo), "v"(hi)); return r; }
__device__ __forceinline__ int opaque_tid() { int t = threadIdx.x; asm volatile("" : "+v"(t)); return t; }
__device__ __forceinline__ float bflo(unsigned u) { return __builtin_bit_cast(float, u << 16); }
__device__ __forceinline__ float bfhi(unsigned u) { return __builtin_bit_cast(float, u & 0xffff0000u); }
__device__ __forceinline__ float sigmoidf_(float x) { return __builtin_amdgcn_rcpf(1.0f + __expf(-x)); }
__device__ __forceinline__ float gelu_tanh(float x) { const float u = 1.5957691216057308f * (x + 0.044715f * x * x * x); return x * sigmoidf_(u); }
__device__ __forceinline__ void swap32(float& a, float& b) { asm volatile("v_nop\n\tv_nop\n\tv_permlane32_swap_b32 %0, %1" : "+v"(a), "+v"(b)); }
__device__ __forceinline__ void swap16(float& a, float& b) { asm volatile("v_nop\n\tv_nop\n\tv_permlane16_swap_b32 %0, %1" : "+v"(a), "+v"(b)); }
__device__ __forceinline__ float quad16_max(float x) {
    { float a = x, b = x; swap32(a, b); x = fmaxf(a, b); }
    { float a = x, b = x; swap16(a, b); x = fmaxf(a, b); }
    return x;
}
__device__ __forceinline__ float quad16_sum(float x) {
    { float a = x, b = x; swap32(a, b); x = a + b; }
    { float a = x, b = x; swap16(a, b); x = a + b; }
    return x;
}
__device__ __forceinline__ float wave_sum(float v) {
#pragma unroll
    for (int o = 1; o < 64; o <<= 1) v += __shfl_xor(v, o);
    return v;
}

namespace pg8 {
constexpr int BM = 256, BK = 64, HALF = 128, HTB = HALF * BK * 2, STAGE_BYTES = 8 * HTB, NXCD = 8, WGM = 4;
__host__ __device__ __forceinline__ int lds_byte(int r, int c) { const int st = (r >> 4) * 2 + (c >> 5), rr = r & 15, cc = c & 31, ob = rr * 64 + cc * 2; return st * 1024 + (ob ^ (((ob >> 9) & 1) << 5)); }
__host__ __device__ __forceinline__ void stage_rc(int b, int& R, int& C) { const int st = b / 1024, sb = b % 1024, swz = sb ^ (((sb >> 9) & 1) << 5); R = (st >> 1) * 16 + swz / 64; C = (st & 1) * 32 + (swz % 64) / 2; }
__host__ __device__ __forceinline__ int perm32(int rho) { const int n = rho >> 4, i = rho & 15; return 8 * (i >> 2) + 4 * n + (i & 3); }

struct Unit { int pm, pn; };
struct Gemm { const bf16_t* A; const bf16_t* Bt; int M, N, K, lda; };

struct StaticOrder {
    int nM, nN, nwg, G, c;
    __device__ void init(int M, int N, int G_, int c_) { nM = M / BM; nN = N / BM; nwg = nM * nN; G = G_; c = c_; }
    __device__ bool next(int i, Unit& u) const {
        const long L = (long)i * G + c; if (L >= nwg) return false;
        int wgid = (int)L; { const int q = nwg / NXCD, r = nwg % NXCD, xcd = wgid % NXCD, off = wgid / NXCD; wgid = (xcd < r ? xcd * (q + 1) : r * (q + 1) + (xcd - r) * q) + off; }
        const int nig = WGM * nN, gid = wgid / nig, fm = gid * WGM, gsz = (nM - fm) < WGM ? (nM - fm) : WGM;
        u.pm = fm + ((wgid % nig) % gsz); u.pn = (wgid % nig) / gsz; return true;
    }
};

template <class Epi, class Sched, bool ALIGN_EPI, bool SP2>
__device__ __forceinline__ void gemm_phase(LAS unsigned char* lds, const Gemm g, const Sched& S, const Epi& E) {
    const int tid = opaque_tid(), wid = __builtin_amdgcn_readfirstlane(tid >> 6), lane = tid & 63, wr = wid >> 2, wc = wid & 3, fr = lane & 15, fq = lane >> 4;
    const int K = g.K, nt = K / BK, lda = g.lda;
    unsigned voffA[2], voffB[2];
#pragma unroll
    for (int i = 0; i < 2; ++i) { int R, C; stage_rc(tid * 16 + i * 8192, R, C); const int Rb = Epi::PERM ? ((R & ~31) + perm32(R & 31)) : R;
        voffA[i] = (unsigned)(R * lda + C) * 2u; voffB[i] = (unsigned)(Rb * K + C) * 2u; }
    const size_t kstep = (size_t)(BK * 2);
    const size_t hstepA = (size_t)HALF * lda * 2, hstepB = (size_t)HALF * K * 2;
    const size_t tstepA = 2 * hstepA, tstepB = 2 * hstepB;
    const unsigned ldsw = (unsigned)wid * 1024u;
    const int aoff = lds_byte(wr * 64 + fr, fq * 8), boff = lds_byte(wc * 32 + fr, fq * 8);
#define PG8_SA(b, h) (((b) * 2 + (h)) * HTB)
#define PG8_SB(b, h) ((4 + (b) * 2 + (h)) * HTB)
#define PG8_STAGE(bufoff, gbase, voff) do { _Pragma("unroll") for (int _i = 0; _i < 2; ++_i) \
        __builtin_amdgcn_global_load_lds((const unsigned*)((const char*)(gbase) + (voff)[_i]), (LAS unsigned*)(lds + (bufoff) + ldsw + _i * 8192), 16, 0, 0); } while (0)
#define PG8_LDA(dst, b, h) do { _Pragma("unroll") for (int m = 0; m < 4; ++m) _Pragma("unroll") for (int k = 0; k < 2; ++k) dst[m][k] = *(const LAS bf16x8*)(lds + PG8_SA(b, h) + aoff + m * 2048 + k * 1024); } while (0)
#define PG8_LDB(dst, b, h) do { _Pragma("unroll") for (int n = 0; n < 2; ++n) _Pragma("unroll") for (int k = 0; k < 2; ++k) dst[n][k] = *(const LAS bf16x8*)(lds + PG8_SB(b, h) + boff + n * 2048 + k * 1024); } while (0)
#define PG8_MMA(ai, bj, At, Bt) do { __builtin_amdgcn_s_setprio(1); _Pragma("unroll") for (int m = 0; m < 4; ++m) _Pragma("unroll") for (int n = 0; n < 2; ++n) _Pragma("unroll") for (int k = 0; k < 2; ++k) \
        acc[ai][bj][m][n] = __builtin_amdgcn_mfma_f32_16x16x32_bf16(Bt[n][k], At[m][k], acc[ai][bj][m][n], 0, 0, 0); __builtin_amdgcn_s_setprio(0); } while (0)
#define PG8_WAIT_V(n) asm volatile("s_waitcnt vmcnt(" #n ")" ::: "memory")
#define PG8_WAIT_L(n) asm volatile("s_waitcnt lgkmcnt(" #n ")" ::: "memory")
#define PG8_BAR __builtin_amdgcn_s_barrier()
#define PG8_SCHED __builtin_amdgcn_sched_barrier(0)
    Unit cur, nxt; int ui = 0;
    if (!S.next(0, cur)) return;
    f32x4 acc[2][2][4][2];
#pragma unroll
    for (int a = 0; a < 2; ++a)
#pragma unroll
        for (int b = 0; b < 2; ++b)
#pragma unroll
            for (int m = 0; m < 4; ++m)
#pragma unroll
                for (int n = 0; n < 2; ++n) acc[a][b][m][n] = (f32x4){0.f, 0.f, 0.f, 0.f};
    bf16x8 At[4][2], B0[2][2], B1[2][2];
    const char* cA = (const char*)g.A + (size_t)cur.pm * tstepA; const char* cB = (const char*)g.Bt + (size_t)cur.pn * tstepB;
    if constexpr (SP2) {
        PG8_STAGE(PG8_SB(0, 0), cB, voffB); PG8_STAGE(PG8_SB(0, 1), cB + hstepB, voffB); PG8_STAGE(PG8_SA(0, 0), cA, voffA); PG8_STAGE(PG8_SA(0, 1), cA + hstepA, voffA);
        if (wr == 1) PG8_BAR;
        PG8_WAIT_V(2); PG8_BAR;
        PG8_STAGE(PG8_SB(1, 0), cB + kstep, voffB); PG8_STAGE(PG8_SA(1, 0), cA + kstep, voffA); PG8_STAGE(PG8_SB(1, 1), cB + hstepB + kstep, voffB);
        PG8_WAIT_V(6); PG8_BAR;
    } else {
        PG8_STAGE(PG8_SB(0, 0), cB, voffB); PG8_STAGE(PG8_SA(0, 0), cA, voffA); PG8_STAGE(PG8_SB(0, 1), cB + hstepB, voffB); PG8_STAGE(PG8_SA(0, 1), cA + hstepA, voffA);
        if (wr == 1) PG8_BAR;
        PG8_WAIT_V(4); PG8_BAR;
        PG8_STAGE(PG8_SB(1, 0), cB + kstep, voffB); PG8_STAGE(PG8_SA(1, 0), cA + kstep, voffA); PG8_STAGE(PG8_SB(1, 1), cB + hstepB + kstep, voffB);
        PG8_WAIT_V(6); PG8_BAR;
    }
    for (;;) {
        const bool has_next = S.next(ui + 1, nxt);
        const char* nA = has_next ? (const char*)g.A + (size_t)nxt.pm * tstepA : cA; const char* nB = has_next ? (const char*)g.Bt + (size_t)nxt.pn * tstepB : cB;
        for (int t = 0; t < nt; t += 2) {
            const bool last = (t == nt - 2);
            const char* a1 = cA + (size_t)(t + 1) * kstep;
            const char* a2 = last ? nA : cA + (size_t)(t + 2) * kstep; const char* b2 = last ? nB : cB + (size_t)(t + 2) * kstep;
            const char* a3 = a2 + kstep; const char* b3 = b2 + kstep;
            if constexpr (Epi::MID_T > 0) { if (t == Epi::MID_T) E.mid(acc, cur, wr, wc, fr, fq); }
            if constexpr (SP2) {
            PG8_LDB(B0, 0, 0); PG8_LDB(B1, 0, 1); PG8_SCHED; PG8_LDA(At, 0, 0); PG8_STAGE(PG8_SA(1, 1), a1 + hstepA, voffA);
            PG8_WAIT_V(8); PG8_WAIT_L(0); PG8_BAR; PG8_MMA(0, 0, At, B0); PG8_MMA(0, 1, At, B1); PG8_BAR; PG8_SCHED;
            PG8_LDA(At, 0, 1); PG8_STAGE(PG8_SB(0, 0), b2, voffB); PG8_STAGE(PG8_SB(0, 1), b2 + hstepB, voffB); PG8_STAGE(PG8_SA(0, 0), a2, voffA);
            PG8_WAIT_V(8); PG8_WAIT_L(0); PG8_BAR; PG8_MMA(1, 0, At, B0); PG8_MMA(1, 1, At, B1); PG8_BAR; PG8_SCHED;
            PG8_LDB(B0, 1, 0); PG8_LDB(B1, 1, 1); PG8_SCHED; PG8_LDA(At, 1, 0); PG8_STAGE(PG8_SA(0, 1), a2 + hstepA, voffA);
            PG8_WAIT_V(8); PG8_WAIT_L(0); PG8_BAR; PG8_MMA(0, 0, At, B0); PG8_MMA(0, 1, At, B1); PG8_BAR; PG8_SCHED;
            PG8_LDA(At, 1, 1); PG8_STAGE(PG8_SB(1, 0), b3, voffB); PG8_STAGE(PG8_SB(1, 1), b3 + hstepB, voffB); PG8_STAGE(PG8_SA(1, 0), a3, voffA);
            PG8_WAIT_V(8); PG8_WAIT_L(0); PG8_BAR; PG8_MMA(1, 0, At, B0); PG8_MMA(1, 1, At, B1); PG8_BAR; PG8_SCHED;
            } else {
            PG8_LDB(B0, 0, 0); PG8_SCHED; PG8_LDA(At, 0, 0); PG8_STAGE(PG8_SA(1, 1), a1 + hstepA, voffA);
            PG8_WAIT_L(8); PG8_BAR; PG8_WAIT_L(0); PG8_MMA(0, 0, At, B0); PG8_BAR; PG8_SCHED;
            PG8_LDB(B1, 0, 1); PG8_STAGE(PG8_SB(0, 0), b2, voffB);
            PG8_BAR; PG8_WAIT_L(0); PG8_MMA(0, 1, At, B1); PG8_BAR;
            PG8_LDA(At, 0, 1); PG8_STAGE(PG8_SA(0, 0), a2, voffA);
            PG8_BAR; PG8_WAIT_L(0); PG8_MMA(1, 0, At, B0); PG8_BAR; PG8_SCHED;
            PG8_STAGE(PG8_SB(0, 1), b2 + hstepB, voffB);
            PG8_WAIT_V(6); PG8_BAR; PG8_MMA(1, 1, At, B1); PG8_BAR;
            PG8_LDB(B0, 1, 0); PG8_SCHED; PG8_LDA(At, 1, 0); PG8_STAGE(PG8_SA(0, 1), a2 + hstepA, voffA);
            PG8_WAIT_L(8); PG8_BAR; PG8_WAIT_L(0); PG8_MMA(0, 0, At, B0); PG8_BAR; PG8_SCHED;
            PG8_LDB(B1, 1, 1); PG8_STAGE(PG8_SB(1, 0), b3, voffB);
            PG8_BAR; PG8_WAIT_L(0); PG8_MMA(0, 1, At, B1); PG8_BAR;
            PG8_LDA(At, 1, 1); PG8_STAGE(PG8_SA(1, 0), a3, voffA);
            PG8_BAR; PG8_WAIT_L(0); PG8_MMA(1, 0, At, B0); PG8_BAR; PG8_SCHED;
            PG8_STAGE(PG8_SB(1, 1), b3 + hstepB, voffB);
            PG8_WAIT_V(6); PG8_BAR; PG8_MMA(1, 1, At, B1); PG8_BAR;
            }
        }
        if constexpr (ALIGN_EPI) { if (wr == 0) PG8_BAR; }
        E(acc, cur, wr, wc, fr, fq);
        if (!has_next) break;
#pragma unroll
        for (int a = 0; a < 2; ++a)
#pragma unroll
            for (int b = 0; b < 2; ++b)
#pragma unroll
                for (int m = 0; m < 4; ++m)
#pragma unroll
                    for (int n = 0; n < 2; ++n) acc[a][b][m][n] = (f32x4){0.f, 0.f, 0.f, 0.f};
        cur = nxt; cA = nA; cB = nB; ++ui;
        if constexpr (ALIGN_EPI) { if (wr == 1) PG8_BAR; }
    }
    PG8_WAIT_V(0);
    if constexpr (!ALIGN_EPI) { if (wr == 0) PG8_BAR; }
    PG8_BAR;
#undef PG8_SA
#undef PG8_SB
#undef PG8_STAGE
#undef PG8_LDA
#undef PG8_LDB
#undef PG8_MMA
#undef PG8_WAIT_V
#undef PG8_WAIT_L
#undef PG8_BAR
#undef PG8_SCHED
}

template <int MODE> struct EpiBf {
    static constexpr bool PERM = true; static constexpr int MID_T = 0;
    bf16_t* O; int ldc; const bf16_t* gate; int ldg; const bf16_t* addend;
    __device__ __forceinline__ void operator()(const f32x4 (&acc)[2][2][4][2], const Unit& u, int wr, int wc, int fr, int fq) const {
        const int row0 = u.pm * BM + wr * 64 + fr, col0 = u.pn * BM + wc * 32 + 8 * fq;
#pragma unroll
        for (int ai = 0; ai < 2; ++ai)
#pragma unroll
            for (int m = 0; m < 4; ++m) { const size_t row = (size_t)(row0 + ai * HALF + m * 16);
#pragma unroll
                for (int bj = 0; bj < 2; ++bj) { f32x4 v0 = acc[ai][bj][m][0], v1 = acc[ai][bj][m][1]; const int col = col0 + bj * HALF;
                    if (MODE >= 1) { const u32x4 gv = *(const u32x4*)(gate + row * ldg + col);
                        v0[0] *= sigmoidf_(bflo(gv.x)); v0[1] *= sigmoidf_(bfhi(gv.x)); v0[2] *= sigmoidf_(bflo(gv.y)); v0[3] *= sigmoidf_(bfhi(gv.y));
                        v1[0] *= sigmoidf_(bflo(gv.z)); v1[1] *= sigmoidf_(bfhi(gv.z)); v1[2] *= sigmoidf_(bflo(gv.w)); v1[3] *= sigmoidf_(bfhi(gv.w)); }
                    if (MODE == 2) { const u32x4 av = *(const u32x4*)(addend + row * ldc + col);
                        v0[0] += bflo(av.x); v0[1] += bfhi(av.x); v0[2] += bflo(av.y); v0[3] += bfhi(av.y);
                        v1[0] += bflo(av.z); v1[1] += bfhi(av.z); v1[2] += bflo(av.w); v1[3] += bfhi(av.w); }
                    u32x4 w; w.x = pk2(v0[0], v0[1]); w.y = pk2(v0[2], v0[3]); w.z = pk2(v1[0], v1[1]); w.w = pk2(v1[2], v1[3]);
                    *(u32x4*)(O + row * ldc + col) = w; } }
    }
};
#define EPI_FENCE() asm volatile("" ::: "memory")
struct EpiMerge {
    static constexpr bool PERM = true; static constexpr int MID_T = AOUT / BK;
    bf16_t* O; const bf16_t* ga; const bf16_t* gr; int ldg;
    __device__ __forceinline__ void mid(f32x4 (&acc)[2][2][4][2], const Unit& u, int wr, int wc, int fr, int fq) const {
        int row0 = u.pm * BM + wr * 64 + fr, col0 = u.pn * BM + wc * 32 + 8 * fq;
        asm volatile("" : "+v"(row0), "+v"(col0));
#pragma unroll
        for (int ah = 0; ah < 4; ++ah) {
            const int ai = ah >> 1, mh = ah & 1;
            u32x4 a[2][2], r[2][2];
#pragma unroll
            for (int mm = 0; mm < 2; ++mm)
#pragma unroll
                for (int bj = 0; bj < 2; ++bj) { const size_t o = (size_t)(row0 + ai * HALF + (2 * mh + mm) * 16) * ldg + col0 + bj * HALF; a[mm][bj] = *(const u32x4*)(ga + o); r[mm][bj] = *(const u32x4*)(gr + o); }
            EPI_FENCE();
#pragma unroll
            for (int mm = 0; mm < 2; ++mm)
#pragma unroll
                for (int bj = 0; bj < 2; ++bj) { const int m = 2 * mh + mm; const u32x4 av = a[mm][bj], rv = r[mm][bj];
                    f32x4& v0 = acc[ai][bj][m][0]; f32x4& v1 = acc[ai][bj][m][1];
                    v0[0] *= sigmoidf_(bflo(av.x)) * (1.0f + __expf(-bflo(rv.x))); v0[1] *= sigmoidf_(bfhi(av.x)) * (1.0f + __expf(-bfhi(rv.x)));
                    v0[2] *= sigmoidf_(bflo(av.y)) * (1.0f + __expf(-bflo(rv.y))); v0[3] *= sigmoidf_(bfhi(av.y)) * (1.0f + __expf(-bfhi(rv.y)));
                    v1[0] *= sigmoidf_(bflo(av.z)) * (1.0f + __expf(-bflo(rv.z))); v1[1] *= sigmoidf_(bfhi(av.z)) * (1.0f + __expf(-bfhi(rv.z)));
                    v1[2] *= sigmoidf_(bflo(av.w)) * (1.0f + __expf(-bflo(rv.w))); v1[3] *= sigmoidf_(bfhi(av.w)) * (1.0f + __expf(-bfhi(rv.w))); }
            EPI_FENCE();
        }
    }
    __device__ __forceinline__ void operator()(const f32x4 (&acc)[2][2][4][2], const Unit& u, int wr, int wc, int fr, int fq) const {
        const int row0 = u.pm * BM + wr * 64 + fr, col0 = u.pn * BM + wc * 32 + 8 * fq;
#pragma unroll
        for (int ah = 0; ah < 4; ++ah) {
            const int ai = ah >> 1, mh = ah & 1;
            u32x4 r[2][2];
#pragma unroll
            for (int mm = 0; mm < 2; ++mm)
#pragma unroll
                for (int bj = 0; bj < 2; ++bj) r[mm][bj] = *(const u32x4*)(gr + (size_t)(row0 + ai * HALF + (2 * mh + mm) * 16) * ldg + col0 + bj * HALF);
            EPI_FENCE();
#pragma unroll
            for (int mm = 0; mm < 2; ++mm)
#pragma unroll
                for (int bj = 0; bj < 2; ++bj) { const int m = 2 * mh + mm; const u32x4 rv = r[mm][bj]; const f32x4 v0 = acc[ai][bj][m][0], v1 = acc[ai][bj][m][1];
                    u32x4 w; w.x = pk2(v0[0] * sigmoidf_(bflo(rv.x)), v0[1] * sigmoidf_(bfhi(rv.x))); w.y = pk2(v0[2] * sigmoidf_(bflo(rv.y)), v0[3] * sigmoidf_(bfhi(rv.y)));
                    w.z = pk2(v1[0] * sigmoidf_(bflo(rv.z)), v1[1] * sigmoidf_(bfhi(rv.z))); w.w = pk2(v1[2] * sigmoidf_(bflo(rv.w)), v1[3] * sigmoidf_(bfhi(rv.w)));
                    *(u32x4*)(O + (size_t)(row0 + ai * HALF + m * 16) * D + col0 + bj * HALF) = w; }
            EPI_FENCE();
        }
    }
};
struct EpiResid {
    static constexpr bool PERM = true; static constexpr int MID_T = 0;
    bf16_t* out; const float* base; const float* gvec;
    __device__ __forceinline__ void operator()(const f32x4 (&acc)[2][2][4][2], const Unit& u, int wr, int wc, int fr, int fq) const {
        const int row0 = u.pm * BM + wr * 64 + fr, col0 = u.pn * BM + wc * 32 + 8 * fq;
        const float* gv = gvec + (size_t)(row0 >> 11) * MOD6 + col0;
        f32x4 g4[2][2];
#pragma unroll
        for (int bj = 0; bj < 2; ++bj)
#pragma unroll
            for (int n = 0; n < 2; ++n) g4[bj][n] = *(const f32x4*)(gv + bj * HALF + 4 * n);
#pragma unroll
        for (int ai = 0; ai < 2; ++ai)
#pragma unroll
            for (int mh = 0; mh < 2; ++mh) {
                f32x4 b[2][2][2];
#pragma unroll
                for (int mm = 0; mm < 2; ++mm)
#pragma unroll
                    for (int bj = 0; bj < 2; ++bj) { const size_t off = (size_t)(row0 + ai * HALF + (2 * mh + mm) * 16) * D + col0 + bj * HALF; b[mm][bj][0] = *(const f32x4*)(base + off); b[mm][bj][1] = *(const f32x4*)(base + off + 4); }
                EPI_FENCE();
#pragma unroll
                for (int mm = 0; mm < 2; ++mm)
#pragma unroll
                    for (int bj = 0; bj < 2; ++bj) { const int m = 2 * mh + mm; const size_t off = (size_t)(row0 + ai * HALF + m * 16) * D + col0 + bj * HALF;
                        const f32x4 v0 = b[mm][bj][0] * ALPHA + g4[bj][0] * acc[ai][bj][m][0], v1 = b[mm][bj][1] * ALPHA + g4[bj][1] * acc[ai][bj][m][1];
                        u32x4 w; w.x = pk2(v0[0], v0[1]); w.y = pk2(v0[2], v0[3]); w.z = pk2(v1[0], v1[1]); w.w = pk2(v1[2], v1[3]);
                        *(u32x4*)(out + off) = w; }
                EPI_FENCE();
            }
    }
};
struct EpiResidLn {
    static constexpr bool PERM = true; static constexpr int MID_T = 0;
    bf16_t* out; const bf16_t* r1; const float* stats; const float* gam; const float* bet; const float* gvec;
    __device__ __forceinline__ void operator()(const f32x4 (&acc)[2][2][4][2], const Unit& u, int wr, int wc, int fr, int fq) const {
        const int row0 = u.pm * BM + wr * 64 + fr, col0 = u.pn * BM + wc * 32 + 8 * fq;
        const float* gv = gvec + (size_t)(row0 >> 11) * MOD6 + col0;
#pragma unroll
        for (int bj = 0; bj < 2; ++bj) {
            f32x4 g4[2], ga[2], be[2];
#pragma unroll
            for (int n = 0; n < 2; ++n) { g4[n] = *(const f32x4*)(gv + bj * HALF + 4 * n); ga[n] = *(const f32x4*)(gam + col0 + bj * HALF + 4 * n) * ALPHA; be[n] = *(const f32x4*)(bet + col0 + bj * HALF + 4 * n) * ALPHA; }
#pragma unroll
            for (int ai = 0; ai < 2; ++ai) {
                u32x4 t[4]; float mean[4], rstd[4];
#pragma unroll
                for (int m = 0; m < 4; ++m) { const int row = row0 + ai * HALF + m * 16; mean[m] = stats[2 * row]; rstd[m] = stats[2 * row + 1]; t[m] = *(const u32x4*)(r1 + (size_t)row * D + col0 + bj * HALF); }
                EPI_FENCE();
#pragma unroll
                for (int m = 0; m < 4; ++m) { const u32x4 tv = t[m];
                    const f32x4 x0 = ((f32x4){bflo(tv.x), bfhi(tv.x), bflo(tv.y), bfhi(tv.y)} - mean[m]) * rstd[m], x1 = ((f32x4){bflo(tv.z), bfhi(tv.z), bflo(tv.w), bfhi(tv.w)} - mean[m]) * rstd[m];
                    const f32x4 v0 = x0 * ga[0] + be[0] + g4[0] * acc[ai][bj][m][0], v1 = x1 * ga[1] + be[1] + g4[1] * acc[ai][bj][m][1];
                    u32x4 w; w.x = pk2(v0[0], v0[1]); w.y = pk2(v0[2], v0[3]); w.z = pk2(v1[0], v1[1]); w.w = pk2(v1[2], v1[3]);
                    *(u32x4*)(out + (size_t)(row0 + ai * HALF + m * 16) * D + col0 + bj * HALF) = w; }
                EPI_FENCE();
            }
        }
    }
};
}

struct Params { const float* in[24]; float* out; unsigned char* ws; };
enum { I_X = 0, I_C, I_WADA, I_BADA, I_WIN, I_RELB, I_LCW, I_LCB, I_LWA, I_LBA, I_LWX, I_LBX, I_LLAM, I_WPA, I_WPL, I_WOUT, I_LN1G, I_LN1B, I_WUP, I_FCW, I_FCB, I_WDN, I_LN2G, I_LN2B };

__device__ __forceinline__ void p0_transpose_item(const float* W, int K, int N, bf16_t* WT, float* scr, int item, int lane, int ldw = 0) {
    if (ldw == 0) ldw = K;
    const int nblk = N / 32, kb = item / nblk, nb = item % nblk, k0 = 64 * kb, n0 = 32 * nb;
#pragma unroll 8
    for (int i = 0; i < 32; ++i) { const int kk = 2 * i + (lane >> 5); scr[kk * 33 + (lane & 31)] = W[(size_t)(k0 + kk) * N + n0 + (lane & 31)]; }
    asm volatile("s_waitcnt lgkmcnt(0)" ::: "memory");
    const int c = lane & 7;
#pragma unroll
    for (int j = 0; j < 4; ++j) { const int n = (lane >> 3) + 8 * j; const float* s = scr + (8 * c) * 33 + n;
        u32x4 o; o.x = pk2(s[0 * 33], s[1 * 33]); o.y = pk2(s[2 * 33], s[3 * 33]); o.z = pk2(s[4 * 33], s[5 * 33]); o.w = pk2(s[6 * 33], s[7 * 33]);
        *(u32x4*)(WT + (size_t)(n0 + n) * ldw + k0 + 8 * c) = o; }
    asm volatile("s_waitcnt lgkmcnt(0)" ::: "memory");
}

__device__ __forceinline__ void phase0(const Params& p, unsigned char* smem, int bid, int G) {
    const int tid = opaque_tid(), lane = tid & 63, wave = tid >> 6;
    unsigned char* ws = p.ws;
    for (int j = bid; j < 192; j += G) {
        float* sc = (float*)smem;
        for (int i = tid; i < NB * D; i += 512) { const int b = i & 31, k = i >> 5; const float v = p.in[I_C][b * D + k]; sc[k * 32 + b] = v / (1.0f + __expf(-v)); }
        __syncthreads();
        const int cl = lane & 31, bh = lane >> 5;
        const float* wp = p.in[I_WADA] + 32 * j + cl;
        f32x4 a0 = (f32x4){0.f, 0.f, 0.f, 0.f}, a1 = a0, a2 = a0, a3 = a0;
#pragma unroll 8
        for (int kk = 0; kk < 128; ++kk) { const int k = 128 * wave + kk; const float wv = wp[(size_t)k * MOD6]; const f32x4* sp = (const f32x4*)(sc + k * 32 + 16 * bh);
            a0 += sp[0] * wv; a1 += sp[1] * wv; a2 += sp[2] * wv; a3 += sp[3] * wv; }
        __syncthreads();
        float* red = (float*)smem;
        { float* rp = red + wave * 1024 + (16 * bh) * 32 + cl;
#pragma unroll
          for (int i = 0; i < 4; ++i) { rp[(i) * 32] = a0[i]; rp[(4 + i) * 32] = a1[i]; rp[(8 + i) * 32] = a2[i]; rp[(12 + i) * 32] = a3[i]; } }
        __syncthreads();
        float* mod = (float*)(ws + WS_MOD);
        for (int o = tid; o < 1024; o += 512) { float sum = 0.f;
#pragma unroll
            for (int w8 = 0; w8 < 8; ++w8) sum += red[w8 * 1024 + o];
            const int b = o >> 5, col = 32 * j + (o & 31); mod[(size_t)b * MOD6 + col] = sum + p.in[I_BADA][col]; }
        __syncthreads();
    }
    float* scr = (float*)(smem + wave * 16384);
    const int gw = bid * 8 + wave, NGW = G * 8;
    constexpr int I_1 = (D / 64) * (INC / 32), I_2 = (AOUT / 64) * (D / 32), I_3 = (D / 64) * (D / 32), I_4 = I_3, I_5 = (D / 64) * (FF2 / 32), I_6 = (FF / 64) * (D / 32), I_7 = 16 * 2;
    constexpr int NIT = I_1 + I_2 + I_3 + I_4 + I_5 + I_6 + 2 * I_7;
    for (int it = gw; it < NIT; it += NGW) {
        int r = it;
        if (r < I_1) { p0_transpose_item(p.in[I_WIN], D, INC, (bf16_t*)(ws + WS_WIN), scr, r, lane); continue; } r -= I_1;
        if (r < I_2) { p0_transpose_item(p.in[I_WPA], AOUT, D, (bf16_t*)(ws + WS_WPA), scr, r, lane, K2); continue; } r -= I_2;
        if (r < I_3) { p0_transpose_item(p.in[I_WPL], D, D, (bf16_t*)(ws + WS_WPA) + AOUT, scr, r, lane, K2); continue; } r -= I_3;
        if (r < I_4) { p0_transpose_item(p.in[I_WOUT], D, D, (bf16_t*)(ws + WS_WOUT), scr, r, lane); continue; } r -= I_4;
        if (r < I_5) { p0_transpose_item(p.in[I_WUP], D, FF2, (bf16_t*)(ws + WS_WUP), scr, r, lane); continue; } r -= I_5;
        if (r < I_6) { p0_transpose_item(p.in[I_WDN], FF, D, (bf16_t*)(ws + WS_WDN), scr, r, lane); continue; } r -= I_6;
        if (r < I_7) { const int blk = r >> 1; p0_transpose_item(p.in[I_LWA] + blk * 4096, 64, 64, (bf16_t*)(ws + WS_WLRU) + blk * 4096, scr, r & 1, lane); continue; } r -= I_7;
        { const int blk = r >> 1; p0_transpose_item(p.in[I_LWX] + blk * 4096, 64, 64, (bf16_t*)(ws + WS_WLRU) + 65536 + blk * 4096, scr, r & 1, lane); }
    }
}

__device__ __forceinline__ void phase_modx(const Params& p, int chunk, int bid, int G) {
    const float* x = p.in[I_X] + (size_t)chunk * MC * D;
    const float* mod = (const float*)(p.ws + WS_MOD) + (size_t)chunk * CB * MOD6;
    bf16_t* U = (bf16_t*)(p.ws + WS_U);
    const int tid = opaque_tid(), c8 = (tid & 127) * 8, rl = tid >> 7;
    for (int tile = bid; tile < MC / 64; tile += G) {
        const int r0 = tile * 64, b = r0 >> 11;
        const float* mp = mod + (size_t)b * MOD6 + c8;
        const f32x4 sh0 = *(const f32x4*)(mp), sh1 = *(const f32x4*)(mp + 4), sc0 = *(const f32x4*)(mp + D) + 1.0f, sc1 = *(const f32x4*)(mp + D + 4) + 1.0f;
#pragma unroll 8
        for (int i = 0; i < 16; ++i) { const size_t off = (size_t)(r0 + rl + 4 * i) * D + c8;
            const f32x4 x0 = *(const f32x4*)(x + off), x1 = *(const f32x4*)(x + off + 4);
            const f32x4 u0 = x0 * sc0 + sh0, u1 = x1 * sc1 + sh1;
            u32x4 w; w.x = pk2(u0[0], u0[1]); w.y = pk2(u0[2], u0[3]); w.z = pk2(u1[0], u1[1]); w.w = pk2(u1[2], u1[3]);
            *(u32x4*)(U + off) = w; }
    }
}

__device__ __forceinline__ void phase_merge(const Params& p, int bid, int G) {
    const bf16_t* og = (const bf16_t*)(p.ws + WS_OG); const float* lse = (const float*)(p.ws + WS_LSE); bf16_t* oa = (bf16_t*)(p.ws + WS_OATT);
    const int nthr = G * 512;
#pragma unroll 2
    for (int i = bid * 512 + opaque_tid(); i < MC * AOUT / 8; i += nthr) {
        const int row = i >> 6, c8 = (i & 63) * 8, h = c8 >> 6;
        const float l0 = lse[(size_t)row * 8 + h], l1 = lse[(size_t)(MC + row) * 8 + h], l2 = lse[(size_t)(2 * MC + row) * 8 + h];
        const float mx = fmaxf(l0, fmaxf(l1, l2));
        float w0 = __expf(l0 - mx), w1 = __expf(l1 - mx), w2 = __expf(l2 - mx);
        const float inv = 1.0f / (w0 + w1 + w2); w0 *= inv; w1 *= inv; w2 *= inv;
        const u32x4 a = *(const u32x4*)(og + (size_t)row * AOUT + c8), b = *(const u32x4*)(og + (size_t)(MC + row) * AOUT + c8), c = *(const u32x4*)(og + (size_t)(2 * MC + row) * AOUT + c8);
        u32x4 o;
        o.x = pk2(w0 * bflo(a.x) + w1 * bflo(b.x) + w2 * bflo(c.x), w0 * bfhi(a.x) + w1 * bfhi(b.x) + w2 * bfhi(c.x));
        o.y = pk2(w0 * bflo(a.y) + w1 * bflo(b.y) + w2 * bflo(c.y), w0 * bfhi(a.y) + w1 * bfhi(b.y) + w2 * bfhi(c.y));
        o.z = pk2(w0 * bflo(a.z) + w1 * bflo(b.z) + w2 * bflo(c.z), w0 * bfhi(a.z) + w1 * bfhi(b.z) + w2 * bfhi(c.z));
        o.w = pk2(w0 * bflo(a.w) + w1 * bflo(b.w) + w2 * bflo(c.w), w0 * bfhi(a.w) + w1 * bfhi(b.w) + w2 * bfhi(c.w));
        *(u32x4*)(oa + (size_t)row * K2 + c8) = o;
    }
}

template <bool SECOND>
__device__ __forceinline__ void phase_ln(const Params& p, int chunk, int bid, int G) {
    const int tid_ = opaque_tid(); const int lane = tid_ & 63, wave = tid_ >> 6;
    float* R = p.out + (size_t)chunk * MC * D;
    const bf16_t* Rb = (const bf16_t*)(p.ws + (SECOND ? WS_OATT : WS_YAG));
    float* stats = (float*)(p.ws + WS_LSE);
    const float* gam = p.in[SECOND ? I_LN2G : I_LN1G]; const float* bet = p.in[SECOND ? I_LN2B : I_LN1B];
    const float* mod = (const float*)(p.ws + WS_MOD) + (size_t)chunk * CB * MOD6;
    bf16_t* U = (bf16_t*)(p.ws + WS_U);
    f32x4 gg[4], bb[4];
#pragma unroll
    for (int j = 0; j < 4; ++j) { gg[j] = *(const f32x4*)(gam + 4 * lane + 256 * j); bb[j] = *(const f32x4*)(bet + 4 * lane + 256 * j); }
    for (int rg = bid * 8 + wave; rg < MC / 16; rg += G * 8) {
        const int rbase = rg * 16, b = rbase >> 11;
        f32x4 sh[4], sc[4];
        if (!SECOND) {
#pragma unroll
            for (int j = 0; j < 4; ++j) { const float* mp = mod + (size_t)b * MOD6 + 4 * lane + 256 * j; sh[j] = *(const f32x4*)(mp + 3 * D); sc[j] = *(const f32x4*)(mp + 4 * D) + 1.0f; } }
#pragma unroll 1
        for (int rr = 0; rr < 16; rr += 2) {
            const int row0 = rbase + rr;
            f32x4 v[2][4]; float s[2] = {0.f, 0.f};
#pragma unroll
            for (int q = 0; q < 2; ++q) { const u32x2* xr = (const u32x2*)(Rb + (size_t)(row0 + q) * D) + lane;
#pragma unroll
                for (int j = 0; j < 4; ++j) { const u32x2 t = xr[64 * j]; v[q][j] = (f32x4){bflo(t.x), bfhi(t.x), bflo(t.y), bfhi(t.y)}; } }
#pragma unroll
            for (int q = 0; q < 2; ++q)
#pragma unroll
                for (int j = 0; j < 4; ++j) s[q] += (v[q][j].x + v[q][j].y) + (v[q][j].z + v[q][j].w);
            const float mean0 = wave_sum(s[0]) * (1.f / D), mean1 = wave_sum(s[1]) * (1.f / D);
            float s2[2] = {0.f, 0.f};
#pragma unroll
            for (int q = 0; q < 2; ++q) { const float mean = q ? mean1 : mean0;
#pragma unroll
                for (int j = 0; j < 4; ++j) { v[q][j] = v[q][j] - mean; s2[q] += (v[q][j].x * v[q][j].x + v[q][j].y * v[q][j].y) + (v[q][j].z * v[q][j].z + v[q][j].w * v[q][j].w); } }
            const float rstd0 = rsqrtf(wave_sum(s2[0]) * (1.f / D) + LN_EPS), rstd1 = rsqrtf(wave_sum(s2[1]) * (1.f / D) + LN_EPS);
            if (!SECOND && lane < 2) { stats[2 * (row0 + lane)] = lane ? mean1 : mean0; stats[2 * (row0 + lane) + 1] = lane ? rstd1 : rstd0; }
#pragma unroll
            for (int j = 0; j < 4; ++j) { const int c = 4 * lane + 256 * j;
#pragma unroll
                for (int q = 0; q < 2; ++q) { const f32x4 y = v[q][j] * (q ? rstd1 : rstd0) * gg[j] + bb[j];
                    if (SECOND) *(f32x4*)(R + (size_t)(row0 + q) * D + c) = y;
                    if (!SECOND) { const f32x4 u = y * sc[j] + sh[j]; u32x2 w; w.x = pk2(u[0], u[1]); w.y = pk2(u[2], u[3]); *(u32x2*)(U + (size_t)(row0 + q) * D + c) = w; } }
            }
        }
    }
}

__device__ __forceinline__ void phase_convgate(const Params& p, int bid, int G) {
    const bf16_t* up = (const bf16_t*)(p.ws + WS_UP); bf16_t* act = (bf16_t*)(p.ws + WS_ACT);
    const float* cw = p.in[I_FCW]; const float* cb = p.in[I_FCB];
    constexpr int RB = 16, NCG = FF / 8;
    const int nthr = G * 512;
    for (int item = bid * 512 + opaque_tid(); item < (MC / RB) * NCG; item += nthr) {
        const int cg = item % NCG, rb = item / NCG, c8 = cg * 8, row0 = rb * RB, t0 = row0 & (SEQ - 1);
        f32x4 wv[3][2], wg[3][2], bv[2], bg[2];
#pragma unroll
        for (int k = 0; k < 3; ++k) { wv[k][0] = *(const f32x4*)(cw + k * FF2 + c8); wv[k][1] = *(const f32x4*)(cw + k * FF2 + c8 + 4);
            wg[k][0] = *(const f32x4*)(cw + k * FF2 + FF + c8); wg[k][1] = *(const f32x4*)(cw + k * FF2 + FF + c8 + 4); }
        bv[0] = *(const f32x4*)(cb + c8); bv[1] = *(const f32x4*)(cb + c8 + 4); bg[0] = *(const f32x4*)(cb + FF + c8); bg[1] = *(const f32x4*)(cb + FF + c8 + 4);
        const bf16_t* rp = up + (size_t)row0 * FF2 + c8;
        u32x4 a2 = (u32x4){0u, 0u, 0u, 0u}, b2 = a2, a1 = a2, b1 = a2;
        if (t0 > 0) { a2 = *(const u32x4*)(rp - 2 * FF2); b2 = *(const u32x4*)(rp - 2 * FF2 + FF); a1 = *(const u32x4*)(rp - FF2); b1 = *(const u32x4*)(rp - FF2 + FF); }
#pragma unroll 4
        for (int i = 0; i < RB; ++i) {
            const u32x4 a0 = *(const u32x4*)(rp + (size_t)i * FF2), b0 = *(const u32x4*)(rp + (size_t)i * FF2 + FF);
            f32x4 v0 = bv[0], v1 = bv[1], g0 = bg[0], g1 = bg[1];
#define CG_ACC(A, B, K) do { \
            v0 += wv[K][0] * (f32x4){bflo(A.x), bfhi(A.x), bflo(A.y), bfhi(A.y)}; v1 += wv[K][1] * (f32x4){bflo(A.z), bfhi(A.z), bflo(A.w), bfhi(A.w)}; \
            g0 += wg[K][0] * (f32x4){bflo(B.x), bfhi(B.x), bflo(B.y), bfhi(B.y)}; g1 += wg[K][1] * (f32x4){bflo(B.z), bfhi(B.z), bflo(B.w), bfhi(B.w)}; } while (0)
            CG_ACC(a2, b2, 0); CG_ACC(a1, b1, 1); CG_ACC(a0, b0, 2);
#undef CG_ACC
            u32x4 o;
            o.x = pk2(gelu_tanh(g0[0]) * v0[0], gelu_tanh(g0[1]) * v0[1]); o.y = pk2(gelu_tanh(g0[2]) * v0[2], gelu_tanh(g0[3]) * v0[3]);
            o.z = pk2(gelu_tanh(g1[0]) * v1[0], gelu_tanh(g1[1]) * v1[1]); o.w = pk2(gelu_tanh(g1[2]) * v1[2], gelu_tanh(g1[3]) * v1[3]);
            *(u32x4*)(act + (size_t)(row0 + i) * FF + c8) = o;
            a2 = a1; b2 = b1; a1 = a0; b1 = b0;
        }
    }
}

typedef short v4i16_t __attribute__((ext_vector_type(4)));
__device__ __forceinline__ s16x4 vtr(const unsigned char* pp) { return __builtin_bit_cast(s16x4, __builtin_amdgcn_ds_read_tr16_b64_v4i16((LAS v4i16_t*)(LAS unsigned char*)pp)); }

struct AttnRegs { u32x4 k[4], v[4]; bf16x8 q0, q1; };
__device__ __forceinline__ void attn_decode(int item, int& b, int& g, int& h, int& d, int& r, int& n) {
    const int sub = item & 15, bgh = item >> 4, bg = bgh >> 3; h = bgh & 7; g = bg % 3; b = bg / 3;
    if (g == 0) { d = 1; r = 0; n = sub; } else if (g == 1) { d = 4; r = sub >> 2; n = sub & 3; } else { d = 16; r = sub; n = 0; }
}
__device__ __forceinline__ void attn_load(const Params& p, int item, AttnRegs& R, int tid) {
    int b, g, h, d, r, n; attn_decode(item, b, g, h, d, r, n);
    const int lane = tid & 63, w = tid >> 6, fr = lane & 15, fq = lane >> 4, hc = (g * 8 + h) * 64;
    const bf16_t* pb = (const bf16_t*)(p.ws + WS_PROJ) + (size_t)b * SEQ * INC;
#pragma unroll
    for (int c = 0; c < 4; ++c) { const int i = tid + 512 * c, j = i >> 3, ch = i & 7;
        R.k[c] = (u32x4){0u, 0u, 0u, 0u}; R.v[c] = (u32x4){0u, 0u, 0u, 0u};
        if (n > 0 || j >= 128) { const int tok = ((n - 1) * 128 + j) * d + r; const bf16_t* q = pb + (size_t)tok * INC + hc + ch * 8; R.k[c] = *(const u32x4*)(q + OFF_K); R.v[c] = *(const u32x4*)(q + OFF_V); } }
    const int qtok = (n * 128 + 16 * w + fr) * d + r;
    const bf16_t* qp = pb + (size_t)qtok * INC + hc + fq * 8;
    R.q0 = *(const bf16x8*)qp; R.q1 = *(const bf16x8*)(qp + 32);
}
__device__ __forceinline__ void attn_compute(const Params& p, unsigned char* smem, int item, AttnRegs& R, int nxt, const float (&bias)[9][4]) {
    const int tid = opaque_tid(), lane = tid & 63, w = tid >> 6, fr = lane & 15, fq = lane >> 4;
    int b, g, h, d, r, n; attn_decode(item, b, g, h, d, r, n);
    unsigned char* Ks = smem; unsigned char* Vs = smem + 36864; float* tb = (float*)(smem + 73728);
#pragma unroll
    for (int c = 0; c < 4; ++c) { const int i = tid + 512 * c, j = i >> 3, ch = i & 7;
        *(u32x4*)(Ks + j * 144 + ch * 16) = R.k[c]; *(u32x4*)(Vs + j * 144 + ch * 16) = R.v[c]; }
    const bf16x8 qf0 = R.q0, qf1 = R.q1;
    const int qtok = (n * 128 + 16 * w + fr) * d + r;
    __syncthreads();
    if (nxt >= 0) attn_load(p, nxt, R, tid);
    f32x4 s[9];
    const int wu = __builtin_amdgcn_readfirstlane(w);
#pragma unroll
    for (int t = 0; t < 9; ++t) {
        const unsigned char* kp = Ks + (16 * (wu + t) + fr) * 144 + fq * 16;
        const bf16x8 k0 = *(const bf16x8*)kp, k1 = *(const bf16x8*)(kp + 64);
        f32x4 z = (f32x4){0.f, 0.f, 0.f, 0.f};
        z = __builtin_amdgcn_mfma_f32_16x16x32_bf16(k0, qf0, z, 0, 0, 0);
        z = __builtin_amdgcn_mfma_f32_16x16x32_bf16(k1, qf1, z, 0, 0, 0);
        const bool live = (n > 0) || (wu + t >= 8);
        f32x4 a;
#pragma unroll
        for (int e = 0; e < 4; ++e) a[e] = z[e] * 0.125f + (live ? bias[t][e] : -1e30f);
        s[t] = a; }
    s16x4 vlo[5][4], vhi[5][4];
#pragma unroll
    for (int pp = 0; pp < 5; ++pp) { const int tA = 2 * pp, tB = (2 * pp + 1 < 9) ? 2 * pp + 1 : 2 * pp;
        const unsigned char* va = Vs + (16 * (wu + tA) + 4 * fq + (fr >> 2)) * 144 + 8 * (fr & 3);
        const unsigned char* vb = Vs + (16 * (wu + tB) + 4 * fq + (fr >> 2)) * 144 + 8 * (fr & 3);
#pragma unroll
        for (int mt = 0; mt < 4; ++mt) { vlo[pp][mt] = vtr(va + 32 * mt); vhi[pp][mt] = vtr(vb + 32 * mt); } }
    float mx = -1e30f;
#pragma unroll
    for (int t = 0; t < 9; ++t)
#pragma unroll
        for (int e = 0; e < 4; ++e) mx = fmaxf(mx, s[t][e]);
    mx = quad16_max(mx);
    float sum = 0.f;
#pragma unroll
    for (int t = 0; t < 9; ++t)
#pragma unroll
        for (int e = 0; e < 4; ++e) { const float pv = __expf(s[t][e] - mx); s[t][e] = pv; sum += pv; }
    sum = quad16_sum(sum);
    f32x4 o[4];
#pragma unroll
    for (int mt = 0; mt < 4; ++mt) o[mt] = (f32x4){0.f, 0.f, 0.f, 0.f};
#pragma unroll
    for (int pp = 0; pp < 5; ++pp) { const int tA = 2 * pp, tB = (2 * pp + 1 < 9) ? 2 * pp + 1 : 2 * pp;
        u32x4 pw; pw.x = pk2(s[tA][0], s[tA][1]); pw.y = pk2(s[tA][2], s[tA][3]);
        if (2 * pp + 1 < 9) { pw.z = pk2(s[tB][0], s[tB][1]); pw.w = pk2(s[tB][2], s[tB][3]); } else { pw.z = 0u; pw.w = 0u; }
        const bf16x8 pf = __builtin_bit_cast(bf16x8, pw);
#pragma unroll
        for (int mt = 0; mt < 4; ++mt) { const s16x4 lo = vlo[pp][mt], hi = vhi[pp][mt];
            bf16x8 vf; vf[0] = lo[0]; vf[1] = lo[1]; vf[2] = lo[2]; vf[3] = lo[3]; vf[4] = hi[0]; vf[5] = hi[1]; vf[6] = hi[2]; vf[7] = hi[3];
            o[mt] = __builtin_amdgcn_mfma_f32_16x16x32_bf16(vf, pf, o[mt], 0, 0, 0); } }
    const float inv = __builtin_amdgcn_rcpf(sum);
    const size_t orow = (size_t)g * MC + (size_t)b * SEQ + qtok;
    bf16_t* op = (bf16_t*)(p.ws + WS_OG) + orow * AOUT + h * 64 + 4 * fq;
#pragma unroll
    for (int mt = 0; mt < 4; ++mt) { u32x2 wv; wv.x = pk2(o[mt][0] * inv, o[mt][1] * inv); wv.y = pk2(o[mt][2] * inv, o[mt][3] * inv); *(u32x2*)(op + 16 * mt) = wv; }
    if (fq == 0) ((float*)(p.ws + WS_LSE))[orow * 8 + h] = mx + __logf(sum);
}

__device__ __forceinline__ void lru_item(const Params& p, unsigned char* smem, int item) {
    const int tid = opaque_tid(), lane = tid & 63, w = tid >> 6, fr = lane & 15, fq = lane >> 4;
    const int b = item >> 4, nb = item & 15, ch0 = nb * 64;
    const bf16_t* pb = (const bf16_t*)(p.ws + WS_PROJ) + (size_t)b * SEQ * INC;
    bf16_t* hgp = (bf16_t*)(p.ws + WS_OATT) + (size_t)b * SEQ * K2 + AOUT + ch0;
    unsigned char* XR = smem;
    unsigned char* WL = smem + 18432;
    constexpr int LRS = 68;
    float* LA = (float*)(smem + 36864);
    float* LB = (float*)(smem + 36864 + 128 * LRS * 4);
    float* CW = (float*)(smem + 36864 + 2 * 128 * LRS * 4);
    float* CBI = CW + 256; float* BA = CW + 320; float* BX = CW + 384; float* SP = CW + 448;
    float* SEG = CW + 512;
    float* CIN = CW + 1536;
    if (tid < 256) CW[tid] = p.in[I_LCW][(tid >> 6) * D + ch0 + (tid & 63)];
    else if (tid < 320) { const int c = tid - 256; CBI[c] = p.in[I_LCB][ch0 + c]; BA[c] = p.in[I_LBA][ch0 + c]; BX[c] = p.in[I_LBX][ch0 + c]; SP[c] = log1pf(__expf(-p.in[I_LLAM][ch0 + c])); }
    { const bf16_t* wl = (const bf16_t*)(p.ws + WS_WLRU);
      for (int i = tid; i < 1024; i += 512) { const int gsel = i >> 9, rr = (i >> 3) & 63, ch = i & 7;
          *(u32x4*)(WL + gsel * 9216 + rr * 144 + ch * 16) = *(const u32x4*)(wl + gsel * 65536 + nb * 4096 + rr * 64 + ch * 8); } }
    float hprev = 0.f;
    const int tt = tid >> 2, c0 = (tid & 3) * 16;
    u32x4 xa[4][2], gq[2];
#define LRU_LOADX(T0) do { _Pragma("unroll") for (int k = 0; k < 4; ++k) { const int t = (T0) + tt - 3 + k; \
        if (t >= 0) { const bf16_t* xp = pb + (size_t)t * INC + OFF_XL + ch0 + c0; xa[k][0] = *(const u32x4*)xp; xa[k][1] = *(const u32x4*)(xp + 8); } \
        else { xa[k][0] = (u32x4){0u, 0u, 0u, 0u}; xa[k][1] = (u32x4){0u, 0u, 0u, 0u}; } } } while (0)
    LRU_LOADX(0);
    for (int seg = 0; seg < SEQ / 128; ++seg) {
        const int t0 = seg * 128;
        __syncthreads();
        {
            float xr[16];
#pragma unroll
            for (int e = 0; e < 16; ++e) xr[e] = CBI[c0 + e];
#pragma unroll
            for (int k = 0; k < 4; ++k) {
                {   const u32x4 a = xa[k][0], bq = xa[k][1];
                    const float* cw = CW + k * 64 + c0;
                    xr[0] += cw[0] * bflo(a.x); xr[1] += cw[1] * bfhi(a.x); xr[2] += cw[2] * bflo(a.y); xr[3] += cw[3] * bfhi(a.y);
                    xr[4] += cw[4] * bflo(a.z); xr[5] += cw[5] * bfhi(a.z); xr[6] += cw[6] * bflo(a.w); xr[7] += cw[7] * bfhi(a.w);
                    xr[8] += cw[8] * bflo(bq.x); xr[9] += cw[9] * bfhi(bq.x); xr[10] += cw[10] * bflo(bq.y); xr[11] += cw[11] * bfhi(bq.y);
                    xr[12] += cw[12] * bflo(bq.z); xr[13] += cw[13] * bfhi(bq.z); xr[14] += cw[14] * bflo(bq.w); xr[15] += cw[15] * bfhi(bq.w); } }
            u32x4 w0, w1; w0.x = pk2(xr[0], xr[1]); w0.y = pk2(xr[2], xr[3]); w0.z = pk2(xr[4], xr[5]); w0.w = pk2(xr[6], xr[7]);
            w1.x = pk2(xr[8], xr[9]); w1.y = pk2(xr[10], xr[11]); w1.z = pk2(xr[12], xr[13]); w1.w = pk2(xr[14], xr[15]);
            *(u32x4*)(XR + tt * 144 + c0 * 2) = w0; *(u32x4*)(XR + tt * 144 + c0 * 2 + 16) = w1;
#pragma unroll
            for (int q = 0; q < 4; ++q) *(f32x4*)(LB + tt * LRS + c0 + 4 * q) = (f32x4){xr[4 * q], xr[4 * q + 1], xr[4 * q + 2], xr[4 * q + 3]};
            { const bf16_t* gp = pb + (size_t)(t0 + tt) * INC + OFF_LG + ch0 + c0; gq[0] = *(const u32x4*)gp; gq[1] = *(const u32x4*)(gp + 8); }
            if (seg + 1 < SEQ / 128) LRU_LOADX(t0 + 128);
        }
        __syncthreads();
        {
            const unsigned char* ap = XR + (16 * w + fr) * 144 + fq * 16;
            const bf16x8 a0 = *(const bf16x8*)ap, a1 = *(const bf16x8*)(ap + 64);
#pragma unroll
            for (int nt = 0; nt < 4; ++nt) {
                const unsigned char* bp = WL + (16 * nt + fr) * 144 + fq * 16;
                const bf16x8 ba0 = *(const bf16x8*)bp, ba1 = *(const bf16x8*)(bp + 64), bx0 = *(const bf16x8*)(bp + 9216), bx1 = *(const bf16x8*)(bp + 9216 + 64);
                f32x4 ar = (f32x4){0.f, 0.f, 0.f, 0.f}, ax = (f32x4){0.f, 0.f, 0.f, 0.f};
                ar = __builtin_amdgcn_mfma_f32_16x16x32_bf16(a0, ba0, ar, 0, 0, 0); ar = __builtin_amdgcn_mfma_f32_16x16x32_bf16(a1, ba1, ar, 0, 0, 0);
                ax = __builtin_amdgcn_mfma_f32_16x16x32_bf16(a0, bx0, ax, 0, 0, 0); ax = __builtin_amdgcn_mfma_f32_16x16x32_bf16(a1, bx1, ax, 0, 0, 0);
                const int dch = 16 * nt + fr; const float bav = BA[dch], bxv = BX[dch], spv = SP[dch];
#pragma unroll
                for (int e = 0; e < 4; ++e) { const int t = 16 * w + 4 * fq + e;
                    const float rr = sigmoidf_(ar[e] + bav), ii = sigmoidf_(ax[e] + bxv);
                    const float la = -8.0f * rr * spv; const float av = __expf(la);
                    const float xv = LB[t * LRS + dch];
                    LA[t * LRS + dch] = av; LB[t * LRS + dch] = __builtin_amdgcn_sqrtf(fmaxf(1.0f - av * av, 0.f)) * (ii * xv); }
            }
        }
        __syncthreads();
        {
            float hh = 0.f, AA = 1.f;
#pragma unroll
            for (int i = 0; i < 16; ++i) { const int idx = (16 * w + i) * LRS + lane; const float av = LA[idx], bv = LB[idx]; hh = av * hh + bv; AA *= av; LB[idx] = hh; LA[idx] = AA; }
            SEG[(w * 64 + lane) * 2] = AA; SEG[(w * 64 + lane) * 2 + 1] = hh;
        }
        __syncthreads();
        {
            float cin = hprev, mine = 0.f;
#pragma unroll
            for (int s2 = 0; s2 < 8; ++s2) { if (s2 == w) mine = cin; cin = SEG[(s2 * 64 + lane) * 2] * cin + SEG[(s2 * 64 + lane) * 2 + 1]; }
            hprev = cin; CIN[w * 64 + lane] = mine;
        }
        __syncthreads();
        {
            const int s2 = tt >> 4; const int t = t0 + tt;
            const u32x4 g0 = gq[0], g1 = gq[1];
            float hv[16];
#pragma unroll
            for (int q = 0; q < 4; ++q) { const f32x4 lb = *(const f32x4*)(LB + tt * LRS + c0 + 4 * q), la = *(const f32x4*)(LA + tt * LRS + c0 + 4 * q), ci = *(const f32x4*)(CIN + s2 * 64 + c0 + 4 * q);
                const f32x4 hq = lb + la * ci; hv[4 * q] = hq[0]; hv[4 * q + 1] = hq[1]; hv[4 * q + 2] = hq[2]; hv[4 * q + 3] = hq[3]; }
            u32x4 o0, o1;
            o0.x = pk2(hv[0] * gelu_tanh(bflo(g0.x)), hv[1] * gelu_tanh(bfhi(g0.x))); o0.y = pk2(hv[2] * gelu_tanh(bflo(g0.y)), hv[3] * gelu_tanh(bfhi(g0.y)));
            o0.z = pk2(hv[4] * gelu_tanh(bflo(g0.z)), hv[5] * gelu_tanh(bfhi(g0.z))); o0.w = pk2(hv[6] * gelu_tanh(bflo(g0.w)), hv[7] * gelu_tanh(bfhi(g0.w)));
            o1.x = pk2(hv[8] * gelu_tanh(bflo(g1.x)), hv[9] * gelu_tanh(bfhi(g1.x))); o1.y = pk2(hv[10] * gelu_tanh(bflo(g1.y)), hv[11] * gelu_tanh(bfhi(g1.y)));
            o1.z = pk2(hv[12] * gelu_tanh(bflo(g1.z)), hv[13] * gelu_tanh(bfhi(g1.z))); o1.w = pk2(hv[14] * gelu_tanh(bflo(g1.w)), hv[15] * gelu_tanh(bfhi(g1.w)));
            *(u32x4*)(hgp + (size_t)t * K2 + c0) = o0; *(u32x4*)(hgp + (size_t)t * K2 + c0 + 8) = o1;
        }
    }
}

constexpr int N_LRU_ITEMS = CB * 16, N_ATT_ITEMS = CB * 384;
__device__ __forceinline__ void phase_mix(const Params& p, unsigned char* smem, int bid, int G) {
    const int tid = opaque_tid();
    for (int it = bid; it < N_LRU_ITEMS; it += G) { __syncthreads(); lru_item(p, smem, it); }
    const int a0 = (int)(((long)N_ATT_ITEMS * bid) / G), a1 = (int)(((long)N_ATT_ITEMS * (bid + 1)) / G);
    AttnRegs R;
#pragma unroll
    for (int c = 0; c < 4; ++c) { R.k[c] = (u32x4){0u, 0u, 0u, 0u}; R.v[c] = (u32x4){0u, 0u, 0u, 0u}; }
    R.q0 = (bf16x8){0, 0, 0, 0, 0, 0, 0, 0}; R.q1 = R.q0;
    if (a0 < a1) attn_load(p, a0, R, tid);
    float bias[9][4];
#pragma unroll
    for (int t = 0; t < 9; ++t)
#pragma unroll
        for (int e = 0; e < 4; ++e) bias[t][e] = 0.f;
    int gh_tb = -1;
    float* tb = (float*)(smem + 73728);
    const int lane = tid & 63, fr = lane & 15, fq = lane >> 4;
    for (int it = a0; it < a1; ++it) {
        __syncthreads();
        const int gh = (it >> 4) % 24;
        if (gh != gh_tb) {
            const int g = gh >> 3, h = gh & 7, d = (g == 0) ? 1 : (g == 1 ? 4 : 16);
            if (tid < 176) { const int dist0 = 144 - tid; float bv = -1e30f;
                if (dist0 >= 0 && dist0 <= 128) { const int dist = dist0 * d; int bucket;
                    if (dist < 16) bucket = dist; else { const float nf = (float)dist; int lg = 16 + (int)(logf(nf / 16.0f) / 4.852030263919617f * 16.0f); bucket = lg < 31 ? lg : 31; }
                    bv = p.in[I_RELB][bucket * 24 + g * 8 + h]; }
                tb[tid] = bv; }
            __syncthreads();
            const float* rt = tb + 16 + 4 * fq - fr;
#pragma unroll
            for (int t = 0; t < 9; ++t)
#pragma unroll
                for (int e = 0; e < 4; ++e) bias[t][e] = rt[16 * t + e];
            gh_tb = gh;
        }
        attn_compute(p, smem, it, R, it + 1 < a1 ? it + 1 : -1, bias);
    }
}

#define XB_TMO      128
#define XB_XCNT(j)  (256  + 64 * (j))
#define XB_XSUB(j)  (1280 + 64 * (j))
#define XB_XGEN(j)  (2304 + 64 * (j))
#define XB_TOP      3328
#define XB_TOPGEN   3392
#define XCD_BAR_WORDS 3456
#define XB_SPIN_CAP (1u << 22)
__device__ __forceinline__ unsigned xb_ld(unsigned* p)              { return __hip_atomic_load(p, __ATOMIC_RELAXED, __HIP_MEMORY_SCOPE_AGENT); }
__device__ __forceinline__ unsigned xb_add(unsigned* p, unsigned v) { return __hip_atomic_fetch_add(p, v, __ATOMIC_RELAXED, __HIP_MEMORY_SCOPE_AGENT); }
__device__ __forceinline__ unsigned xb_xcc_id() { return (unsigned)__builtin_amdgcn_s_getreg((3 << 11) | 20) & 0xFu; }
#define XB_SPIN(cond, bar) do { unsigned _sp = 0; while (cond) { __builtin_amdgcn_s_sleep(1); \
    if ((++_sp & 255u) == 0u) { if (xb_ld(&(bar)[XB_TMO])) break; if (_sp > XB_SPIN_CAP) { atomicAdd(&(bar)[XB_TMO], 1u); break; } } } } while (0)
struct XcdBarrier { unsigned* bar; unsigned x; volatile LAS unsigned* st; };
__device__ __forceinline__ XcdBarrier xcd_barrier_post(unsigned* bar, volatile LAS unsigned* st) {
    XcdBarrier b; b.bar = bar; b.x = xb_xcc_id(); b.st = st;
    if (threadIdx.x == 0) (void)xb_add(&bar[XB_XCNT(b.x)], 1u);
    return b;
}
__device__ __forceinline__ void xcd_barrier_complete(unsigned* bar, unsigned x, unsigned& nloc, unsigned& nx) {
    const unsigned G = gridDim.x * gridDim.y * gridDim.z;
    unsigned sum, cnt, mine, sp = 0u;
    for (;;) {
        sum = 0u; cnt = 0u; mine = 0u;
#pragma unroll
        for (unsigned j = 0; j < 16; ++j) { const unsigned c = xb_ld(&bar[XB_XCNT(j)]); sum += c; cnt += (c > 0u) ? 1u : 0u; mine = (j == x) ? c : mine; }
        if (sum == G) break;
        __builtin_amdgcn_s_sleep(1);
        if ((++sp & 255u) == 0u) { if (xb_ld(&bar[XB_TMO])) break; if (sp > XB_SPIN_CAP) { atomicAdd(&bar[XB_TMO], 1u); break; } }
    }
    nloc = mine > 0u ? mine : 1u; nx = cnt > 0u ? cnt : 1u;
}
__device__ __forceinline__ void xcd_barrier(const XcdBarrier& b) {
    asm volatile("s_waitcnt vmcnt(0)" ::: "memory");
    __syncthreads();
    if (threadIdx.x == 0) {
        unsigned* bar = b.bar;
        unsigned bx = b.x;
        asm volatile("" : "+s"(bx));
        __builtin_amdgcn_s_waitcnt(0);
        unsigned nloc = b.st[0], nx = b.st[1];
        if (nloc == 0u) { xcd_barrier_complete(bar, bx, nloc, nx); b.st[0] = nloc; b.st[1] = nx; }
        const unsigned old = xb_add(&bar[XB_XSUB(bx)], 1u);
        const unsigned gen = old / nloc;
        if (old + 1u == (gen + 1u) * nloc) {
            __builtin_amdgcn_fence(__ATOMIC_RELEASE, "agent");
            asm volatile("s_waitcnt vmcnt(0)" ::: "memory");
            const unsigned og = xb_add(&bar[XB_TOP], 1u);
            const unsigned tg = og / nx;
            if (og + 1u == (tg + 1u) * nx) xb_add(&bar[XB_TOPGEN], 1u);
            else XB_SPIN(xb_ld(&bar[XB_TOPGEN]) == tg, bar);
            __builtin_amdgcn_fence(__ATOMIC_ACQUIRE, "agent");
            xb_add(&bar[XB_XGEN(bx)], 1u);
            asm volatile("s_waitcnt vmcnt(0)" ::: "memory");
        } else {
            XB_SPIN(xb_ld(&bar[XB_XGEN(bx)]) == gen, bar);
            __builtin_amdgcn_fence(__ATOMIC_ACQUIRE, "agent");
            asm volatile("s_waitcnt vmcnt(0)" ::: "memory");
        }
    }
    __syncthreads();
}

__global__ void __launch_bounds__(512, 2) mega_fwd(Params p) {
    extern __shared__ __attribute__((aligned(16))) unsigned char smem[];
    cg::grid_group grid = cg::this_grid();
    const int G = gridDim.x, bid = blockIdx.x;
    LAS unsigned char* lds = (LAS unsigned char*)smem;
    unsigned char* ws = p.ws;
    unsigned* ctl = (unsigned*)(ws + WS_CTL);

    unsigned nbar = 0;
#if TIMECAT
    unsigned t_last = (unsigned)__builtin_amdgcn_s_memrealtime(), t_acc = 0;
#define STAMP(cat) do { const unsigned _n = (unsigned)__builtin_amdgcn_s_memrealtime(); if ((cat) == TIMECAT) t_acc += _n - t_last; t_last = _n; } while (0)
#else
#define STAMP(cat) do {} while (0)
#endif
#define GSYNC() xcd_barrier(xbar)
    volatile LAS unsigned* xst = (volatile LAS unsigned*)(lds + LDS_BYTES - 64);
    if (threadIdx.x < 2) xst[threadIdx.x] = 0u;
    __syncthreads();
    const XcdBarrier xbar = xcd_barrier_post(ctl + 4096, xst);
    grid.sync();
    phase0(p, smem, bid, G);
    GSYNC(); STAMP(4);
    phase_modx(p, 0, bid, G);
    GSYNC(); STAMP(3);
#pragma unroll 1
    for (int ch = 0; ch < NCH; ++ch) {
        const float* mod = (const float*)(ws + WS_MOD) + (size_t)ch * CB * MOD6;
        {
            pg8::Gemm g{(const bf16_t*)(ws + WS_U), (const bf16_t*)(ws + WS_WIN), MC, INC, D, D}; pg8::StaticOrder S; S.init(MC, INC, G, bid);
            pg8::EpiBf<0> E{(bf16_t*)(ws + WS_PROJ), INC, nullptr, 0, nullptr};
            pg8::gemm_phase<pg8::EpiBf<0>, pg8::StaticOrder, true, true>(lds, g, S, E);
        }
        GSYNC(); STAMP(1);
        phase_mix(p, smem, bid, G);
        GSYNC(); STAMP(2);
        phase_merge(p, bid, G);
        GSYNC(); STAMP(3);
        {
            pg8::Gemm g{(const bf16_t*)(ws + WS_OATT), (const bf16_t*)(ws + WS_WPA), MC, D, K2, K2}; pg8::StaticOrder S; S.init(MC, D, G, bid);
            pg8::EpiMerge E{(bf16_t*)(ws + WS_MRG), (const bf16_t*)(ws + WS_PROJ) + OFF_GA, (const bf16_t*)(ws + WS_PROJ) + OFF_GR, INC};
            pg8::gemm_phase<pg8::EpiMerge, pg8::StaticOrder, true, true>(lds, g, S, E);
        }
        GSYNC(); STAMP(5);
        {
            pg8::Gemm g{(const bf16_t*)(ws + WS_MRG), (const bf16_t*)(ws + WS_WOUT), MC, D, D, D}; pg8::StaticOrder S; S.init(MC, D, G, bid);
            pg8::EpiResid E{(bf16_t*)(ws + WS_YAG), p.in[I_X] + (size_t)ch * MC * D, mod + 2 * D};
            pg8::gemm_phase<pg8::EpiResid, pg8::StaticOrder, true, true>(lds, g, S, E);
        }
        GSYNC(); STAMP(5);
        phase_ln<false>(p, ch, bid, G);
        GSYNC(); STAMP(3);
        {
            pg8::Gemm g{(const bf16_t*)(ws + WS_U), (const bf16_t*)(ws + WS_WUP), MC, FF2, D, D}; pg8::StaticOrder S; S.init(MC, FF2, G, bid);
            pg8::EpiBf<0> E{(bf16_t*)(ws + WS_UP), FF2, nullptr, 0, nullptr};
            pg8::gemm_phase<pg8::EpiBf<0>, pg8::StaticOrder, true, true>(lds, g, S, E);
        }
        GSYNC(); STAMP(1);
        phase_convgate(p, bid, G);
        GSYNC(); STAMP(3);
        {
            pg8::Gemm g{(const bf16_t*)(ws + WS_ACT), (const bf16_t*)(ws + WS_WDN), MC, D, FF, FF}; pg8::StaticOrder S; S.init(MC, D, G, bid);
            pg8::EpiResidLn E{(bf16_t*)(ws + WS_OATT), (const bf16_t*)(ws + WS_YAG), (const float*)(ws + WS_LSE), p.in[I_LN1G], p.in[I_LN1B], mod + 5 * D};
            pg8::gemm_phase<pg8::EpiResidLn, pg8::StaticOrder, true, true>(lds, g, S, E);
        }
        GSYNC(); STAMP(1);
        phase_ln<true>(p, ch, bid, G);
        if (ch + 1 < NCH) { phase_modx(p, ch + 1, bid, G); GSYNC(); STAMP(3); }
    }
#if TIMECAT
    GSYNC(); STAMP(3);
#endif
#if TIMECAT
    if (bid == 0) {
        const int nel = (int)(t_acc / 10);
        for (int i = opaque_tid(); i < nel; i += 512) p.out[(size_t)i * 64 + 7] += 0.125f;
    }
#endif
}

extern "C" void kernel_launch(void* const* d_in, const int* in_sizes, int n_in, void* d_out, int out_size, void* d_ws, size_t ws_size, hipStream_t stream) {
    static int grid = 0;
    if (grid == 0) {
        int dev = 0, cus = 0, per_cu = 0;
        (void)hipGetDevice(&dev);
        (void)hipDeviceGetAttribute(&cus, hipDeviceAttributeMultiprocessorCount, dev);
        if (hipFuncSetAttribute((const void*)mega_fwd, hipFuncAttributeMaxDynamicSharedMemorySize, LDS_BYTES) != hipSuccess) fprintf(stderr, "kernel_launch: hipFuncSetAttribute failed\n");
        if (hipOccupancyMaxActiveBlocksPerMultiprocessor(&per_cu, (const void*)mega_fwd, 512, LDS_BYTES) != hipSuccess || per_cu < 1) { fprintf(stderr, "kernel_launch: occupancy query says %d\n", per_cu); per_cu = 1; }
        (void)hipGetLastError();
        grid = cus * per_cu;
        if (n_in != 24 || ws_size < WS_END) fprintf(stderr, "kernel_launch: unexpected n_in %d / ws_size %zu (need %zu)\n", n_in, ws_size, (size_t)WS_END);
    }
    (void)hipMemsetAsync((char*)d_ws + WS_CTL, 0, CTL_BYTES, stream);
    Params p{};
    for (int i = 0; i < 24; ++i) p.in[i] = (const float*)d_in[i];
    p.out = (float*)d_out; p.ws = (unsigned char*)d_ws;
    void* args[] = {&p};
    hipError_t e = hipLaunchCooperativeKernel((const void*)mega_fwd, dim3(grid), dim3(512), args, LDS_BYTES, stream);
    if (e != hipSuccess) fprintf(stderr, "kernel_launch: cooperative launch failed: %s (grid %d)\n", hipGetErrorString(e), grid);
}
```
